# Optimizing an MI355X kernel written in HIP

```python
import math
import jax, jax.numpy as jnp
from jax import lax
import numpy as np

D_MODEL = 1024
BATCH = 8
SEQ = 2048
DEPTH = 1
DEC_BATCH = 128
DEC_SEQ = 8
PAST_LEN = 16384
PAGE_SIZE = 128

HEAD_DIM = 64
N_RET_HEADS = 8
RET_WIDTH = N_RET_HEADS * HEAD_DIM
N_SWA_HEADS = 8
N_SWA_KV = 2
SWA_GROUP = N_SWA_HEADS // N_SWA_KV
SWA_WIDTH = N_SWA_HEADS * HEAD_DIM
SWA_KV_WIDTH = N_SWA_KV * HEAD_DIM
MIX_WIDTH = RET_WIDTH + SWA_WIDTH
IN_WIDTH = 4 * RET_WIDTH + SWA_WIDTH + 2 * SWA_KV_WIDTH
D_FF = 4 * D_MODEL
WINDOW = 128
RET_CHUNK = 128
EPS = 1e-6
NEG_INF = -1e30

kernel_name = "hymba_retention_swa_sink_decode_step"


def rms_norm(x, gain=None):
    xf = x.astype(jnp.float32)
    y = xf * lax.rsqrt(jnp.mean(xf * xf, axis=-1, keepdims=True) + EPS)
    if gain is not None:
        y = y * gain.astype(jnp.float32)
    return y.astype(x.dtype)


def retention_log_decay():
    return jnp.log(1.0 - 2.0 ** (-5.0 - jnp.arange(N_RET_HEADS, dtype=jnp.float32)))


def alibi_slopes():
    return 2.0 ** (-8.0 * jnp.arange(1, N_SWA_HEADS + 1, dtype=jnp.float32) / N_SWA_HEADS)


def retention(q, k, v, s0, chunk):
    b, t, h, d = q.shape
    n = t // chunk
    dt = q.dtype
    log_g = retention_log_decay()
    idx = jnp.arange(chunk, dtype=jnp.float32)
    diff = idx[:, None] - idx[None, :]
    intra = jnp.where(diff >= 0, jnp.exp(log_g[:, None, None] * jnp.maximum(diff, 0.0)), 0.0).astype(dt)
    q_decay = jnp.exp(log_g[:, None] * (idx + 1.0)).astype(dt)
    k_decay = jnp.exp(log_g[:, None] * (chunk - 1.0 - idx)).astype(dt)
    s_decay = jnp.exp(log_g * chunk).astype(dt)
    k = k * (d ** -0.5)

    def to_chunks(a):
        return a.reshape(b, n, chunk, h, a.shape[-1]).transpose(1, 0, 3, 2, 4)

    qc, kc, vc = to_chunks(q), to_chunks(k), to_chunks(v)

    def step(s, inp):
        qi, ki, vi = inp
        scores = jnp.einsum('bhld,bhmd->bhlm', qi, ki) * intra
        o = (jnp.einsum('bhlm,bhme->bhle', scores, vi)
             + jnp.einsum('bhld,bhde->bhle', qi * q_decay[..., None], s))
        s = s * s_decay[:, None, None] + jnp.einsum('bhld,bhle->bhde', ki * k_decay[..., None], vi)
        return s, o

    s, o = lax.scan(step, s0.astype(dt), (qc, kc, vc))
    o = o.transpose(1, 0, 3, 2, 4).reshape(b, t, h, v.shape[-1])
    return o, s


def sink_softmax(scores, sinks):
    sink = sinks.astype(jnp.float32).reshape(N_SWA_KV, SWA_GROUP)[:, :, None, None]
    sink_col = jnp.broadcast_to(sink, scores.shape[:-1] + (1,))
    p = jax.nn.softmax(jnp.concatenate([scores, sink_col], axis=-1), axis=-1)
    return p[..., :-1]


def swa_prompt(q, k, v, sinks):
    b, t, h, d = q.shape
    w = WINDOW
    n = t // w
    qb = q.reshape(b, n, w, N_SWA_KV, SWA_GROUP, d)
    kb = k.reshape(b, n, w, N_SWA_KV, d)
    vb = v.reshape(b, n, w, N_SWA_KV, d)
    pad = jnp.zeros_like(kb[:, :1])
    kk = jnp.concatenate([jnp.concatenate([pad, kb[:, :-1]], axis=1), kb], axis=2)
    vv = jnp.concatenate([jnp.concatenate([pad.astype(vb.dtype), vb[:, :-1]], axis=1), vb], axis=2)
    i = jnp.arange(w)[:, None]
    j = jnp.arange(2 * w)[None, :]
    dist = w + i - j
    key_pos = jnp.arange(n)[:, None, None] * w - w + j[None]
    valid = (dist >= 0)[None] & (dist < w)[None] & (key_pos >= 0)
    slopes = alibi_slopes().reshape(N_SWA_KV, SWA_GROUP)[:, :, None, None]
    scores = jnp.einsum('bnqkgd,bnskd->bnkgqs', qb, kk).astype(jnp.float32) * (d ** -0.5)
    scores = scores - slopes * dist.astype(jnp.float32)
    scores = jnp.where(valid[None, :, None, None], scores, NEG_INF)
    probs = sink_softmax(scores, sinks).astype(v.dtype)
    out = jnp.einsum('bnkgqs,bnskd->bnqkgd', probs, vv)
    return out.reshape(b, t, h * d)


def swa_sample(q, k, v, kbuf, vbuf, sinks):
    b, t, h, d = q.shape
    wb = kbuf.shape[1]
    kk = jnp.concatenate([kbuf.astype(k.dtype), k], axis=1)
    vv = jnp.concatenate([vbuf.astype(v.dtype), v], axis=1)
    i = jnp.arange(t)[:, None]
    j = jnp.arange(wb + t)[None, :]
    dist = wb + i - j
    valid = (dist >= 0) & (dist < WINDOW)
    slopes = alibi_slopes().reshape(N_SWA_KV, SWA_GROUP)[:, :, None, None]
    qg = q.reshape(b, t, N_SWA_KV, SWA_GROUP, d)
    scores = jnp.einsum('bqkgd,bskd->bkgqs', qg, kk).astype(jnp.float32) * (d ** -0.5)
    scores = scores - slopes * dist.astype(jnp.float32)
    scores = jnp.where(valid, scores, NEG_INF)
    probs = sink_softmax(scores, sinks).astype(v.dtype)
    out = jnp.einsum('bkgqs,bskd->bqkgd', probs, vv).reshape(b, t, h * d)
    return out, kk[:, -wb:], vv[:, -wb:]


def decoder_layer(x, ret_state, win_k, win_v, norm_mix_gain, w_in, q_norm_gain, k_norm_gain,
                  attn_sinks, w_out, norm_ffn_gain, w_up, w_down):
    b, t, _ = x.shape
    hn = rms_norm(x, norm_mix_gain)
    proj = hn @ w_in
    cuts = np.cumsum([RET_WIDTH] * 4 + [SWA_WIDTH, SWA_KV_WIDTH]).tolist()
    q_r, k_r, v_r, g_r, q_s, k_s, v_s = jnp.split(proj, cuts, axis=-1)

    q_r = q_r.reshape(b, t, N_RET_HEADS, HEAD_DIM)
    k_r = k_r.reshape(b, t, N_RET_HEADS, HEAD_DIM)
    v_r = v_r.reshape(b, t, N_RET_HEADS, HEAD_DIM)
    if ret_state is None:
        ret_state = jnp.zeros((b, N_RET_HEADS, HEAD_DIM, HEAD_DIM), x.dtype)
    chunk = RET_CHUNK if t % RET_CHUNK == 0 else t
    o_r, new_ret = retention(q_r, k_r, v_r, ret_state, chunk)
    o_r = rms_norm(o_r).reshape(b, t, RET_WIDTH) * jax.nn.silu(g_r)

    q_s = rms_norm(q_s.reshape(b, t, N_SWA_HEADS, HEAD_DIM), q_norm_gain)
    k_s = rms_norm(k_s.reshape(b, t, N_SWA_KV, HEAD_DIM), k_norm_gain)
    v_s = v_s.reshape(b, t, N_SWA_KV, HEAD_DIM)
    if win_k is None:
        o_s = swa_prompt(q_s, k_s, v_s, attn_sinks)
        new_k, new_v = k_s[:, -WINDOW:], v_s[:, -WINDOW:]
    else:
        o_s, new_k, new_v = swa_sample(q_s, k_s, v_s, win_k, win_v, attn_sinks)

    h = x + jnp.concatenate([o_r, o_s], axis=-1) @ w_out
    hf = rms_norm(h, norm_ffn_gain)
    h = h + jnp.square(jax.nn.relu(hf @ w_up)) @ w_down
    return h, new_ret, new_k, new_v


def setup_inputs(seed: int = 0) -> dict:
    key = jax.random.key(seed)
    ks = jax.random.split(key, 14)
    wb = min(WINDOW, PAST_LEN)
    f32 = jnp.float32
    return {
        "x_prompt": jax.random.normal(ks[0], (BATCH, SEQ, D_MODEL), f32),
        "x_sample": jax.random.normal(ks[1], (DEC_BATCH, DEC_SEQ, D_MODEL), f32),
        "state_ret": 0.5 * jax.random.normal(ks[2], (DEC_BATCH, N_RET_HEADS, HEAD_DIM, HEAD_DIM), f32),
        "cache_swa_k": jax.random.normal(ks[3], (DEC_BATCH, wb, N_SWA_KV, HEAD_DIM), f32),
        "cache_swa_v": jax.random.normal(ks[4], (DEC_BATCH, wb, N_SWA_KV, HEAD_DIM), f32),
        "norm_mix_gain": 1.0 + 0.02 * jax.random.normal(ks[5], (D_MODEL,), f32),
        "w_in": jax.random.normal(ks[6], (D_MODEL, IN_WIDTH), f32) * D_MODEL ** -0.5,
        "q_norm_gain": 1.0 + 0.02 * jax.random.normal(ks[7], (HEAD_DIM,), f32),
        "k_norm_gain": 1.0 + 0.02 * jax.random.normal(ks[8], (HEAD_DIM,), f32),
        "attn_sinks": jax.random.normal(ks[9], (N_SWA_HEADS,), f32),
        "w_out": jax.random.normal(ks[10], (MIX_WIDTH, D_MODEL), f32) * MIX_WIDTH ** -0.5,
        "norm_ffn_gain": 1.0 + 0.02 * jax.random.normal(ks[11], (D_MODEL,), f32),
        "w_up": jax.random.normal(ks[12], (D_MODEL, D_FF), f32) * D_MODEL ** -0.5,
        "w_down": jax.random.normal(ks[13], (D_FF, D_MODEL), f32) * D_FF ** -0.5,
    }


def reference(x_prompt, x_sample, state_ret, cache_swa_k, cache_swa_v, norm_mix_gain, w_in,
              q_norm_gain, k_norm_gain, attn_sinks, w_out, norm_ffn_gain, w_up, w_down):
    y_prompt, y_sample = x_prompt, x_sample
    for _ in range(DEPTH):
        y_prompt, ret_p, k_p, v_p = decoder_layer(
            y_prompt, None, None, None, norm_mix_gain, w_in, q_norm_gain, k_norm_gain,
            attn_sinks, w_out, norm_ffn_gain, w_up, w_down)
        y_sample, ret_s, k_s, v_s = decoder_layer(
            y_sample, state_ret, cache_swa_k, cache_swa_v, norm_mix_gain, w_in, q_norm_gain,
            k_norm_gain, attn_sinks, w_out, norm_ffn_gain, w_up, w_down)
    return (y_prompt, y_sample, ret_p, k_p, v_p, ret_s, k_s, v_s)
```

```cpp
#include <hip/hip_runtime.h>
#include <hip/hip_cooperative_groups.h>
#include <cstdio>
#include <cstdint>
namespace cg = cooperative_groups;
namespace pg8 {
#define PG8_LAS __attribute__((address_space(3)))
typedef unsigned short bf16_t;
typedef short bf16x8 __attribute__((ext_vector_type(8)));
typedef float f32x4 __attribute__((ext_vector_type(4)));
typedef unsigned u32x4 __attribute__((ext_vector_type(4)));
constexpr int BM = 256, BK = 64, HALF = 128, HTB = HALF * BK * 2  , STAGE_BYTES = 8 * HTB, NXCD = 8, WGM = 8;

__host__ __device__ __forceinline__ int lds_byte(int r, int c) { const int st = (r >> 4) * 2 + (c >> 5), rr = r & 15, cc = c & 31, ob = rr * 64 + cc * 2; return st * 1024 + (ob ^ (((ob >> 9) & 1) << 5)); }
__host__ __device__ __forceinline__ void stage_rc(int b, int& R, int& C) { const int st = b / 1024, sb = b % 1024, swz = sb ^ (((sb >> 9) & 1) << 5); R = (st >> 1) * 16 + swz / 64; C = (st & 1) * 32 + (swz % 64) / 2; }
__host__ __device__ __forceinline__ int perm32(int rho) { const int n = rho >> 4, i = rho & 15; return 8 * (i >> 2) + 4 * n + (i & 3); }

struct Unit { int pm, pn; };
struct Gemm { const bf16_t* A; const bf16_t* Bt; int M, N, K; };

struct StaticOrder {
    int nM, nN, nwg, G, c;
    __host__ __device__ void init(int M, int N, int G_, int c_) { nM = M / BM; nN = N / BM; nwg = nM * nN; G = G_; c = c_; }
    __host__ __device__ bool next(int i, Unit& u) const {
        const long L = (long)i * G + c; if (L >= nwg) return false;
        int wgid = (int)L; { const int q = nwg / NXCD, r = nwg % NXCD, xcd = wgid % NXCD, off = wgid / NXCD; wgid = (xcd < r ? xcd * (q + 1) : r * (q + 1) + (xcd - r) * q) + off; }
        const int nig = WGM * nN, gid = wgid / nig, fm = gid * WGM, gsz = (nM - fm) < WGM ? (nM - fm) : WGM;
        u.pm = fm + ((wgid % nig) % gsz); u.pn = (wgid % nig) / gsz; return true;
    }
    __device__ __forceinline__ void a_ready(const Unit&) const {}
    __device__ __forceinline__ void done(const Unit&) const {}
};

__device__ __forceinline__ unsigned cvt_pk_bf16(float lo, float hi) { unsigned r; asm volatile("v_cvt_pk_bf16_f32 %0, %1, %2" : "=v"(r) : "v"(lo), "v"(hi)); return r; }
typedef float f32x2 __attribute__((ext_vector_type(2)));
typedef unsigned u32x2 __attribute__((ext_vector_type(2)));
constexpr int MROWS_PROMPT = 16384;
constexpr float RMS_EPS = 1e-6f;

template <int MODE> struct EpiBf16 {
    static constexpr bool PERM = true, AFTER_DRAIN = false;
    bf16_t* O; int ldc; const float* rowss;
    __device__ __forceinline__ void operator()(const f32x4 (&acc)[2][2][4][2], const Unit& u, int wr, int wc, int fr, int fq) const {
        const int row0 = u.pm * BM + wr * 64 + fr, col0 = u.pn * BM + wc * 32 + 8 * fq;
#pragma unroll
        for (int ai = 0; ai < 2; ++ai)
#pragma unroll
            for (int m = 0; m < 4; ++m) {
                const int row = row0 + ai * HALF + m * 16;
                float sc = 1.f;
                if (MODE == 1) sc = __builtin_amdgcn_rsqf(rowss[row] * (1.0f / 1024.0f) + RMS_EPS);
                bf16_t* rowp = O + (size_t)row * ldc + col0;
#pragma unroll
                for (int bj = 0; bj < 2; ++bj) {
                    f32x4 v0 = acc[ai][bj][m][0], v1 = acc[ai][bj][m][1];
                    if (MODE == 1) {
                        v0 = v0 * sc; v1 = v1 * sc;
#pragma unroll
                        for (int e = 0; e < 4; ++e) { const float a = fmaxf(v0[e], 0.f), b = fmaxf(v1[e], 0.f); v0[e] = a * a; v1[e] = b * b; }
                    }
                    u32x4 w; w.x = cvt_pk_bf16(v0[0], v0[1]); w.y = cvt_pk_bf16(v0[2], v0[3]); w.z = cvt_pk_bf16(v1[0], v1[1]); w.w = cvt_pk_bf16(v1[2], v1[3]);
                    *(u32x4*)(rowp + bj * HALF) = w;
                }
            }
    }
};

struct EpiRes {
    static constexpr bool PERM = false, AFTER_DRAIN = false;
    const float* xp; const float* xs; float* out; bf16_t* hb; float* rowss;
    __device__ __forceinline__ void operator()(const f32x4 (&acc)[2][2][4][2], const Unit& u, int wr, int wc, int fr, int fq) const {
        const int row0 = u.pm * BM + wr * 64 + fr, col0 = u.pn * BM + wc * 32 + 4 * fq;
#pragma unroll
        for (int ai = 0; ai < 2; ++ai)
#pragma unroll
            for (int m = 0; m < 4; ++m) {
                const int row = row0 + ai * HALF + m * 16;
                const float* xrow = (row < MROWS_PROMPT) ? xp + (size_t)row * 1024 : xs + (size_t)(row - MROWS_PROMPT) * 1024;
                float ss = 0.f;
#pragma unroll
                for (int bj = 0; bj < 2; ++bj)
#pragma unroll
                    for (int n = 0; n < 2; ++n) {
                        const int col = col0 + bj * HALF + n * 16;
                        const f32x4 h = *(const f32x4*)(xrow + col) + acc[ai][bj][m][n];
                        *(f32x4*)(out + (size_t)row * 1024 + col) = h;
                        ss += (h[0] * h[0] + h[1] * h[1]) + (h[2] * h[2] + h[3] * h[3]);
                        u32x2 w; w.x = cvt_pk_bf16(h[0], h[1]); w.y = cvt_pk_bf16(h[2], h[3]);
                        *(u32x2*)(hb + (size_t)row * 1024 + col) = w;
                    }
                ss += __shfl_xor(ss, 16); ss += __shfl_xor(ss, 32);
                if (fq == 0) __hip_atomic_fetch_add(rowss + row, ss, __ATOMIC_RELAXED, __HIP_MEMORY_SCOPE_AGENT);
            }
    }
};

struct EpiDown {
    static constexpr bool PERM = false, AFTER_DRAIN = false;
    float* out;
    __device__ __forceinline__ void operator()(const f32x4 (&acc)[2][2][4][2], const Unit& u, int wr, int wc, int fr, int fq) const {
        const int row0 = u.pm * BM + wr * 64 + fr, col0 = u.pn * BM + wc * 32 + 4 * fq;
#pragma unroll
        for (int ai = 0; ai < 2; ++ai)
#pragma unroll
            for (int m = 0; m < 4; ++m) {
                float* orow = out + (size_t)(row0 + ai * HALF + m * 16) * 1024 + col0;
#pragma unroll
                for (int bj = 0; bj < 2; ++bj)
#pragma unroll
                    for (int n = 0; n < 2; ++n) { float* p = orow + bj * HALF + n * 16; *(f32x4*)p = *(const f32x4*)p + acc[ai][bj][m][n]; }
            }
    }
};
template <class Epi, class Sched, bool ALIGN_EPI = false, bool SP2 = false>
__device__ __forceinline__ void gemm_phase(PG8_LAS unsigned char* lds, const Gemm g, const Sched& S, const Epi& E) {
    const int tid = threadIdx.x, wid = __builtin_amdgcn_readfirstlane(tid >> 6), lane = tid & 63, wr = wid >> 2, wc = wid & 3, fr = lane & 15, fq = lane >> 4;
    const int K = g.K, nt = K / BK;
    unsigned voffA[2], voffB[2];
#pragma unroll
    for (int i = 0; i < 2; ++i) { int R, C; stage_rc(tid * 16 + i * 8192, R, C); const int Rb = Epi::PERM ? ((R & ~31) + perm32(R & 31)) : R;
        voffA[i] = (unsigned)(R * K + C) * 2u; voffB[i] = (unsigned)(Rb * K + C) * 2u; }
    const size_t kstep = (size_t)(BK * 2);
    const size_t hstep = (size_t)HALF * K * 2;
    const size_t tstep = 2 * hstep;
    const unsigned ldsw = (unsigned)wid * 1024u;
    const int aoff = lds_byte(wr * 64 + fr, fq * 8), boff = lds_byte(wc * 32 + fr, fq * 8);
#define PG8_SA(b, h) (((b) * 2 + (h)) * HTB)
#define PG8_SB(b, h) ((4 + (b) * 2 + (h)) * HTB)
#define PG8_STAGE(bufoff, gbase, voff) do { _Pragma("unroll") for (int _i = 0; _i < 2; ++_i) \
        __builtin_amdgcn_global_load_lds((const unsigned*)((const char*)(gbase) + (voff)[_i]), (PG8_LAS unsigned*)(lds + (bufoff) + ldsw + _i * 8192), 16, 0, 0); } while (0)
#define PG8_LDA(dst, b, h) do { _Pragma("unroll") for (int m = 0; m < 4; ++m) _Pragma("unroll") for (int k = 0; k < 2; ++k) dst[m][k] = *(const PG8_LAS bf16x8*)(lds + PG8_SA(b, h) + aoff + m * 2048 + k * 1024); } while (0)
#define PG8_LDB(dst, b, h) do { _Pragma("unroll") for (int n = 0; n < 2; ++n) _Pragma("unroll") for (int k = 0; k < 2; ++k) dst[n][k] = *(const PG8_LAS bf16x8*)(lds + PG8_SB(b, h) + boff + n * 2048 + k * 1024); } while (0)
#define PG8_MMA(ai, bj, At, Bt) do { __builtin_amdgcn_s_setprio(1); _Pragma("unroll") for (int m = 0; m < 4; ++m) _Pragma("unroll") for (int n = 0; n < 2; ++n) _Pragma("unroll") for (int k = 0; k < 2; ++k) \
        acc[ai][bj][m][n] = __builtin_amdgcn_mfma_f32_16x16x32_bf16(Bt[n][k], At[m][k], acc[ai][bj][m][n], 0, 0, 0); __builtin_amdgcn_s_setprio(0); } while (0)
#define PG8_WAIT_V(n) asm volatile("s_waitcnt vmcnt(" #n ")" ::: "memory")
#define PG8_WAIT_L(n) asm volatile("s_waitcnt lgkmcnt(" #n ")" ::: "memory")
#define PG8_BAR __builtin_amdgcn_s_barrier()
#define PG8_SCHED __builtin_amdgcn_sched_barrier(0)
    Unit cur, nxt; int ui = 0;
    if (!S.next(0, cur)) return;
    f32x4 acc[2][2][4][2];
#pragma unroll
    for (int a = 0; a < 2; ++a)
#pragma unroll
        for (int b = 0; b < 2; ++b)
#pragma unroll
            for (int m = 0; m < 4; ++m)
#pragma unroll
                for (int n = 0; n < 2; ++n) acc[a][b][m][n] = (f32x4){0.f, 0.f, 0.f, 0.f};
    bf16x8 At[4][2], B0[2][2], B1[2][2];
    const char* cA = (const char*)g.A + (size_t)cur.pm * tstep; const char* cB = (const char*)g.Bt + (size_t)cur.pn * tstep;
    S.a_ready(cur);
    if constexpr (SP2) {
        PG8_STAGE(PG8_SB(0, 0), cB, voffB); PG8_STAGE(PG8_SB(0, 1), cB + hstep, voffB); PG8_STAGE(PG8_SA(0, 0), cA, voffA); PG8_STAGE(PG8_SA(0, 1), cA + hstep, voffA);
        if (wr == 1) PG8_BAR;
        PG8_WAIT_V(2); PG8_BAR;
        PG8_STAGE(PG8_SB(1, 0), cB + kstep, voffB); PG8_STAGE(PG8_SA(1, 0), cA + kstep, voffA); PG8_STAGE(PG8_SB(1, 1), cB + hstep + kstep, voffB);
        PG8_WAIT_V(6); PG8_BAR;
    } else {
        PG8_STAGE(PG8_SB(0, 0), cB, voffB); PG8_STAGE(PG8_SA(0, 0), cA, voffA); PG8_STAGE(PG8_SB(0, 1), cB + hstep, voffB); PG8_STAGE(PG8_SA(0, 1), cA + hstep, voffA);
        if (wr == 1) PG8_BAR;
        PG8_WAIT_V(4); PG8_BAR;
        PG8_STAGE(PG8_SB(1, 0), cB + kstep, voffB); PG8_STAGE(PG8_SA(1, 0), cA + kstep, voffA); PG8_STAGE(PG8_SB(1, 1), cB + hstep + kstep, voffB);
        PG8_WAIT_V(6); PG8_BAR;
    }
    for (;;) {
        const bool has_next = S.next(ui + 1, nxt);
        const char* nA = has_next ? (const char*)g.A + (size_t)nxt.pm * tstep : cA; const char* nB = has_next ? (const char*)g.Bt + (size_t)nxt.pn * tstep : cB;
        for (int t = 0; t < nt; t += 2) {
            const bool last = (t == nt - 2);
            const char* a1 = cA + (size_t)(t + 1) * kstep;
            const char* a2 = last ? nA : cA + (size_t)(t + 2) * kstep; const char* b2 = last ? nB : cB + (size_t)(t + 2) * kstep;
            const char* a3 = a2 + kstep; const char* b3 = b2 + kstep;
            if (last && has_next) S.a_ready(nxt);
            if constexpr (SP2) {
            PG8_LDB(B0, 0, 0); PG8_LDB(B1, 0, 1); PG8_SCHED; PG8_LDA(At, 0, 0); PG8_STAGE(PG8_SA(1, 1), a1 + hstep, voffA);
            PG8_WAIT_V(8); PG8_WAIT_L(0); PG8_BAR; PG8_MMA(0, 0, At, B0); PG8_MMA(0, 1, At, B1); PG8_BAR; PG8_SCHED;
            PG8_LDA(At, 0, 1); PG8_STAGE(PG8_SB(0, 0), b2, voffB); PG8_STAGE(PG8_SB(0, 1), b2 + hstep, voffB); PG8_STAGE(PG8_SA(0, 0), a2, voffA);
            PG8_WAIT_V(8); PG8_WAIT_L(0); PG8_BAR; PG8_MMA(1, 0, At, B0); PG8_MMA(1, 1, At, B1); PG8_BAR; PG8_SCHED;
            PG8_LDB(B0, 1, 0); PG8_LDB(B1, 1, 1); PG8_SCHED; PG8_LDA(At, 1, 0); PG8_STAGE(PG8_SA(0, 1), a2 + hstep, voffA);
            PG8_WAIT_V(8); PG8_WAIT_L(0); PG8_BAR; PG8_MMA(0, 0, At, B0); PG8_MMA(0, 1, At, B1); PG8_BAR; PG8_SCHED;
            PG8_LDA(At, 1, 1); PG8_STAGE(PG8_SB(1, 0), b3, voffB); PG8_STAGE(PG8_SB(1, 1), b3 + hstep, voffB); PG8_STAGE(PG8_SA(1, 0), a3, voffA);
            PG8_WAIT_V(8); PG8_WAIT_L(0); PG8_BAR; PG8_MMA(1, 0, At, B0); PG8_MMA(1, 1, At, B1); PG8_BAR; PG8_SCHED;
            } else {
            PG8_LDB(B0, 0, 0); PG8_SCHED; PG8_LDA(At, 0, 0); PG8_STAGE(PG8_SA(1, 1), a1 + hstep, voffA);
            PG8_WAIT_L(8); PG8_BAR; PG8_WAIT_L(0); PG8_MMA(0, 0, At, B0); PG8_BAR; PG8_SCHED;
            PG8_LDB(B1, 0, 1); PG8_STAGE(PG8_SB(0, 0), b2, voffB);
            PG8_BAR; PG8_WAIT_L(0); PG8_MMA(0, 1, At, B1); PG8_BAR;
            PG8_LDA(At, 0, 1); PG8_STAGE(PG8_SA(0, 0), a2, voffA);
            PG8_BAR; PG8_WAIT_L(0); PG8_MMA(1, 0, At, B0); PG8_BAR; PG8_SCHED;
            PG8_STAGE(PG8_SB(0, 1), b2 + hstep, voffB);
            PG8_WAIT_V(6); PG8_BAR; PG8_MMA(1, 1, At, B1); PG8_BAR;
            PG8_LDB(B0, 1, 0); PG8_SCHED; PG8_LDA(At, 1, 0); PG8_STAGE(PG8_SA(0, 1), a2 + hstep, voffA);
            PG8_WAIT_L(8); PG8_BAR; PG8_WAIT_L(0); PG8_MMA(0, 0, At, B0); PG8_BAR; PG8_SCHED;
            PG8_LDB(B1, 1, 1); PG8_STAGE(PG8_SB(1, 0), b3, voffB);
            PG8_BAR; PG8_WAIT_L(0); PG8_MMA(0, 1, At, B1); PG8_BAR;
            PG8_LDA(At, 1, 1); PG8_STAGE(PG8_SA(1, 0), a3, voffA);
            PG8_BAR; PG8_WAIT_L(0); PG8_MMA(1, 0, At, B0); PG8_BAR; PG8_SCHED;
            PG8_STAGE(PG8_SB(1, 1), b3 + hstep, voffB);
            PG8_WAIT_V(6); PG8_BAR; PG8_MMA(1, 1, At, B1); PG8_BAR;
            }
        }
        if constexpr (ALIGN_EPI) { if (wr == 0) PG8_BAR; }
        if constexpr (!Epi::AFTER_DRAIN) { E(acc, cur, wr, wc, fr, fq); S.done(cur); }
        if (!has_next) break;
#pragma unroll
        for (int a = 0; a < 2; ++a)
#pragma unroll
            for (int b = 0; b < 2; ++b)
#pragma unroll
                for (int m = 0; m < 4; ++m)
#pragma unroll
                    for (int n = 0; n < 2; ++n) acc[a][b][m][n] = (f32x4){0.f, 0.f, 0.f, 0.f};
        cur = nxt; cA = nA; cB = nB; ++ui;
        if constexpr (ALIGN_EPI) { if (wr == 1) PG8_BAR; }
    }
    PG8_WAIT_V(0);
    if constexpr (!ALIGN_EPI) { if (wr == 0) PG8_BAR; }
    PG8_BAR;
    if constexpr (Epi::AFTER_DRAIN) { E.fused(acc, cur, wr, wc, fr, fq, lds, wid, lane); S.done(cur); }
#undef PG8_SA
#undef PG8_SB
#undef PG8_STAGE
#undef PG8_LDA
#undef PG8_LDB
#undef PG8_MMA
#undef PG8_WAIT_V
#undef PG8_WAIT_L
#undef PG8_BAR
#undef PG8_SCHED
}
}
#define LAS __attribute__((address_space(3)))
typedef unsigned short bf16_t;
typedef short bf16x8 __attribute__((ext_vector_type(8)));
typedef float f32x4 __attribute__((ext_vector_type(4)));
typedef unsigned u32x4 __attribute__((ext_vector_type(4)));
typedef unsigned u32x2 __attribute__((ext_vector_type(2)));
typedef LAS unsigned char lds8;

constexpr int D = 1024, INW = 2816, FF = 4096;
constexpr int MP = 16384, MS = 1024, M = MP + MS;
constexpr int C_QR = 0, C_KR = 512, C_VR = 1024, C_GR = 1536, C_QS = 2048, C_KS = 2560, C_VS = 2688;
constexpr size_t O_RETP = 17825792, O_KP = 18087936, O_VP = 18219008, O_RETS = 18350080, O_KS = 22544384, O_VS = 24641536;
constexpr size_t MiB = 1u << 20;
constexpr size_t WS_CTL = 0, WS_WIN = 1 * MiB, WS_WOUT = 7 * MiB, WS_WUP = 9 * MiB, WS_WDN = 17 * MiB;
constexpr size_t WS_XN = 25 * MiB;
constexpr size_t WS_PROJ = 59 * MiB;
constexpr size_t WS_MIX = 153 * MiB;
constexpr size_t WS_U = 59 * MiB;
constexpr size_t WS_UST = 196 * MiB;
constexpr int LDS_BYTES = 147456;
constexpr float EPS = 1e-6f, LOG2E = 1.4426950408889634f;

__device__ __forceinline__ unsigned pkbf(float lo, float hi) { return pg8::cvt_pk_bf16(lo, hi); }
__device__ __forceinline__ float bflo(unsigned u) { return __uint_as_float(u << 16); }
__device__ __forceinline__ float bfhi(unsigned u) { return __uint_as_float(u & 0xffff0000u); }
__device__ __forceinline__ float bf2f(bf16_t h) { return __uint_as_float((unsigned)h << 16); }
__device__ __forceinline__ void unpack8(const u32x4 v, float (&f)[8]) { f[0] = bflo(v.x); f[1] = bfhi(v.x); f[2] = bflo(v.y); f[3] = bfhi(v.y); f[4] = bflo(v.z); f[5] = bfhi(v.z); f[6] = bflo(v.w); f[7] = bfhi(v.w); }
__device__ __forceinline__ u32x4 pack8(const float (&f)[8]) { u32x4 o; o.x = pkbf(f[0], f[1]); o.y = pkbf(f[2], f[3]); o.z = pkbf(f[4], f[5]); o.w = pkbf(f[6], f[7]); return o; }
__device__ __forceinline__ bf16x8 ldsr128(const lds8* p) { return *(const LAS bf16x8*)p; }
__device__ __forceinline__ void ldsw128(lds8* p, u32x4 v) { *(LAS u32x4*)p = v; }
__device__ __forceinline__ void ldsw64(lds8* p, u32x2 v) { *(LAS u32x2*)p = v; }
__device__ __forceinline__ void ldsw16(lds8* p, unsigned v) { *(LAS unsigned short*)p = (unsigned short)v; }
__device__ __forceinline__ f32x4 mfma16(bf16x8 a, bf16x8 b, f32x4 c) { return __builtin_amdgcn_mfma_f32_16x16x32_bf16(a, b, c, 0, 0, 0); }
__device__ __forceinline__ float wave_sum(float v) {
#pragma unroll
    for (int o = 1; o < 64; o <<= 1) v += __shfl_xor(v, o);
    return v;
}
__device__ __forceinline__ float wave_max(float v) {
#pragma unroll
    for (int o = 1; o < 64; o <<= 1) v = fmaxf(v, __shfl_xor(v, o));
    return v;
}
__device__ __forceinline__ float ex2(float x) { return __builtin_amdgcn_exp2f(x); }

__device__ __forceinline__ void transpose_item(const float* __restrict__ W, int K, int N, bf16_t* __restrict__ WT, const float* __restrict__ gain, LAS float* scr, int item, int lane) {
    const int nblk = N / 32, kb = item / nblk, nb = item % nblk, k0 = 64 * kb, n0 = 32 * nb;
#pragma unroll 8
    for (int i = 0; i < 32; ++i) { const int kk = 2 * i + (lane >> 5); const float g = gain ? gain[k0 + kk] : 1.f; scr[kk * 33 + (lane & 31)] = W[(size_t)(k0 + kk) * N + n0 + (lane & 31)] * g; }
    asm volatile("s_waitcnt lgkmcnt(0)" ::: "memory");
    const int c = lane & 7;
#pragma unroll
    for (int j = 0; j < 4; ++j) { const int n = (lane >> 3) + 8 * j; const LAS float* s = scr + (8 * c) * 33 + n;
        u32x4 o; o.x = pkbf(s[0 * 33], s[1 * 33]); o.y = pkbf(s[2 * 33], s[3 * 33]); o.z = pkbf(s[4 * 33], s[5 * 33]); o.w = pkbf(s[6 * 33], s[7 * 33]);
        *(u32x4*)(WT + (size_t)(n0 + n) * K + k0 + 8 * c) = o; }
    asm volatile("s_waitcnt lgkmcnt(0)" ::: "memory");
}
__device__ __forceinline__ void rms_row_to_bf16(const float* __restrict__ xrow, const float* __restrict__ gain, bf16_t* __restrict__ orow, int lane) {
    const f32x4* xr = (const f32x4*)xrow + lane; const f32x4* gr = (const f32x4*)gain + lane;
    f32x4 v[4]; float s = 0.f;
#pragma unroll
    for (int j = 0; j < 4; ++j) { v[j] = xr[64 * j]; s += (v[j].x * v[j].x + v[j].y * v[j].y) + (v[j].z * v[j].z + v[j].w * v[j].w); }
    const float rstd = 1.0f / sqrtf(wave_sum(s) * (1.f / D) + EPS);
    u32x2* o8 = (u32x2*)orow + lane;
#pragma unroll
    for (int j = 0; j < 4; ++j) { const f32x4 g = gr[64 * j]; u32x2 o; o.x = pkbf(v[j].x * rstd * g.x, v[j].y * rstd * g.y); o.y = pkbf(v[j].z * rstd * g.z, v[j].w * rstd * g.w); o8[64 * j] = o; }
}

__device__ __forceinline__ void swa_prompt_item(lds8* lds, const bf16_t* __restrict__ proj, bf16_t* __restrict__ mix, float* __restrict__ out,
                                                const float* __restrict__ qg, const float* __restrict__ kg, const float* __restrict__ sinks, int b, int n, int kvh, int h0, int nh) {
    const int tid = threadIdx.x, lane = tid & 63, w = __builtin_amdgcn_readfirstlane(tid >> 6), r = lane & 15, q = lane >> 4;
    constexpr int KS = 0, KSTR = 144, VT = 36864, VSTR = 528, QS = 70656, QSTR = 144, PS = 89088, PSTR = 336, PWAVE = 5376;
    const size_t rowb = (size_t)b * 2048;
    for (int idx = tid; idx < 2048; idx += 512) {
        const int row = idx >> 3, seg = idx & 7, t = (n - 1) * 128 + row;
        float kf[8]; u32x4 vr = (u32x4){0u, 0u, 0u, 0u};
        if (t >= 0) { const bf16_t* p = proj + (rowb + t) * INW + C_KS + kvh * 64 + seg * 8; const u32x4 kr = *(const u32x4*)p; vr = *(const u32x4*)(p + 128); unpack8(kr, kf); }
        else {
#pragma unroll
            for (int e = 0; e < 8; ++e) kf[e] = 0.f; }
        float ss = 0.f;
#pragma unroll
        for (int e = 0; e < 8; ++e) ss += kf[e] * kf[e];
        ss += __shfl_xor(ss, 1); ss += __shfl_xor(ss, 2); ss += __shfl_xor(ss, 4);
        const float rstd = 1.0f / sqrtf(ss * (1.f / 64.f) + EPS);
#pragma unroll
        for (int e = 0; e < 8; ++e) kf[e] *= rstd * kg[seg * 8 + e];
        ldsw128(lds + KS + row * KSTR + seg * 16, pack8(kf));
        lds8* vt = lds + VT + (seg * 8) * VSTR + row * 2;
        ldsw16(vt + 0 * VSTR, vr.x & 0xffffu); ldsw16(vt + 1 * VSTR, vr.x >> 16); ldsw16(vt + 2 * VSTR, vr.y & 0xffffu); ldsw16(vt + 3 * VSTR, vr.y >> 16);
        ldsw16(vt + 4 * VSTR, vr.z & 0xffffu); ldsw16(vt + 5 * VSTR, vr.z >> 16); ldsw16(vt + 6 * VSTR, vr.w & 0xffffu); ldsw16(vt + 7 * VSTR, vr.w >> 16);
        if (n == 15 && h0 == 0 && row >= 128) {
            const size_t dst = ((size_t)(b * 128 + row - 128) * 2 + kvh) * 64 + seg * 8;
            float vf[8]; unpack8(vr, vf);
            *(f32x4*)(out + O_KP + dst) = (f32x4){kf[0], kf[1], kf[2], kf[3]}; *(f32x4*)(out + O_KP + dst + 4) = (f32x4){kf[4], kf[5], kf[6], kf[7]};
            *(f32x4*)(out + O_VP + dst) = (f32x4){vf[0], vf[1], vf[2], vf[3]}; *(f32x4*)(out + O_VP + dst + 4) = (f32x4){vf[4], vf[5], vf[6], vf[7]};
        }
    }
    for (int hh = h0; hh < h0 + nh; ++hh) {
        const int head = kvh * 4 + hh;
        __syncthreads();
        for (int idx = tid; idx < 1024; idx += 512) {
            const int row = idx >> 3, seg = idx & 7;
            const bf16_t* p = proj + (rowb + n * 128 + row) * INW + C_QS + head * 64 + seg * 8;
            float qf[8]; unpack8(*(const u32x4*)p, qf);
            float ss = 0.f;
#pragma unroll
            for (int e = 0; e < 8; ++e) ss += qf[e] * qf[e];
            ss += __shfl_xor(ss, 1); ss += __shfl_xor(ss, 2); ss += __shfl_xor(ss, 4);
            const float rstd = (0.125f * LOG2E) / sqrtf(ss * (1.f / 64.f) + EPS);
#pragma unroll
            for (int e = 0; e < 8; ++e) qf[e] *= rstd * qg[seg * 8 + e];
            ldsw128(lds + QS + row * QSTR + seg * 16, pack8(qf));
        }
        __syncthreads();
        const float slope2 = exp2f(-(float)(head + 1)) * LOG2E, sink2 = sinks[head] * LOG2E;
        const bf16x8 yq0 = ldsr128(lds + QS + (16 * w + r) * QSTR + 16 * q), yq1 = ldsr128(lds + QS + (16 * w + r) * QSTR + 16 * q + 64);
        f32x4 sc[9];
#pragma unroll
        for (int j = 0; j < 9; ++j) {
            const lds8* kp = lds + KS + (16 * (w + j) + r) * KSTR + 16 * q;
            sc[j] = mfma16(ldsr128(kp), yq0, (f32x4){0.f, 0.f, 0.f, 0.f});
            sc[j] = mfma16(ldsr128(kp + 64), yq1, sc[j]);
        }
        const int qi = 16 * w + r;
        float mx = sink2;
#pragma unroll
        for (int j = 0; j < 9; ++j)
#pragma unroll
            for (int i = 0; i < 4; ++i) {
                const int key = 16 * (w + j) + 4 * q + i, dist = 128 + qi - key;
                const bool valid = (dist >= 0) && (dist < 128) && (n > 0 || key >= 128);
                const float v = valid ? sc[j][i] - slope2 * (float)dist : -1e30f;
                sc[j][i] = v; mx = fmaxf(mx, v);
            }
        mx = fmaxf(mx, __shfl_xor(mx, 16)); mx = fmaxf(mx, __shfl_xor(mx, 32));
        float sum = 0.f;
#pragma unroll
        for (int j = 0; j < 9; ++j)
#pragma unroll
            for (int i = 0; i < 4; ++i) { const float p = ex2(sc[j][i] - mx); sc[j][i] = p; sum += p; }
        sum += __shfl_xor(sum, 16); sum += __shfl_xor(sum, 32);
        const float inv = 1.0f / (sum + ex2(sink2 - mx));
        lds8* pw = lds + PS + w * PWAVE + r * PSTR;
#pragma unroll
        for (int j = 0; j < 9; ++j) { const int slot = j + (w & 1); u32x2 v; v.x = pkbf(sc[j][0] * inv, sc[j][1] * inv); v.y = pkbf(sc[j][2] * inv, sc[j][3] * inv); ldsw64(pw + (slot * 16 + 4 * q) * 2, v); }
        { const int zs = (w & 1) ? 0 : 9; ldsw64(pw + (zs * 16 + 4 * q) * 2, (u32x2){0u, 0u}); }
        f32x4 o[4];
#pragma unroll
        for (int et = 0; et < 4; ++et) o[et] = (f32x4){0.f, 0.f, 0.f, 0.f};
        const int s0 = 16 * (w & ~1);
#pragma unroll
        for (int ks = 0; ks < 5; ++ks) {
            const bf16x8 yp = ldsr128(pw + (32 * ks + 8 * q) * 2);
#pragma unroll
            for (int et = 0; et < 4; ++et) o[et] = mfma16(ldsr128(lds + VT + (16 * et + r) * VSTR + (s0 + 32 * ks + 8 * q) * 2), yp, o[et]);
        }
        bf16_t* op = mix + (rowb + n * 128 + qi) * 1024 + 512 + head * 64 + 4 * q;
#pragma unroll
        for (int et = 0; et < 4; ++et) { u32x2 v; v.x = pkbf(o[et][0], o[et][1]); v.y = pkbf(o[et][2], o[et][3]); *(u32x2*)(op + 16 * et) = v; }
    }
    __syncthreads();
}

constexpr int RQ = 0, RK = 18432, RVT = 36864, RKD = 54272, RP = 71680, RST = 106496, RSTR = 144, TSTR = 272;
__device__ __forceinline__ void ret_stage(lds8* lds, const bf16_t* __restrict__ proj, size_t rowbase, int h, float lg2, bool full) {
    const int tid = threadIdx.x;
    for (int idx = tid; idx < 1024; idx += 512) {
        const int row = idx >> 3, seg = idx & 7;
        const bf16_t* p = proj + (rowbase + row) * INW + h * 64 + seg * 8;
        const u32x4 kr = *(const u32x4*)(p + C_KR), vr = *(const u32x4*)(p + C_VR);
        float kf[8]; unpack8(kr, kf);
        const float kd = exp2f(lg2 * (float)(127 - row)) * 0.125f;
        lds8* kt = lds + RKD + (seg * 8) * TSTR + row * 2;
#pragma unroll
        for (int e = 0; e < 8; e += 2) { const unsigned pk = pkbf(kf[e] * kd, kf[e + 1] * kd); ldsw16(kt + e * TSTR, pk & 0xffffu); ldsw16(kt + (e + 1) * TSTR, pk >> 16); }
        lds8* vt = lds + RVT + (seg * 8) * TSTR + row * 2;
        ldsw16(vt + 0 * TSTR, vr.x & 0xffffu); ldsw16(vt + 1 * TSTR, vr.x >> 16); ldsw16(vt + 2 * TSTR, vr.y & 0xffffu); ldsw16(vt + 3 * TSTR, vr.y >> 16);
        ldsw16(vt + 4 * TSTR, vr.z & 0xffffu); ldsw16(vt + 5 * TSTR, vr.z >> 16); ldsw16(vt + 6 * TSTR, vr.w & 0xffffu); ldsw16(vt + 7 * TSTR, vr.w >> 16);
        if (full) {
#pragma unroll
            for (int e = 0; e < 8; ++e) kf[e] *= 0.125f;
            ldsw128(lds + RK + row * RSTR + seg * 16, pack8(kf));
            ldsw128(lds + RQ + row * RSTR + seg * 16, *(const u32x4*)(p + C_QR));
        }
    }
}
__device__ __forceinline__ void ret_state_update(const lds8* lds, f32x4 (&st)[2], int w, int r, int q, float dec) {
    const int et = w >> 1, dt0 = 2 * (w & 1);
    st[0] = st[0] * dec; st[1] = st[1] * dec;
#pragma unroll
    for (int ks = 0; ks < 4; ++ks) {
        const bf16x8 a = ldsr128(lds + RVT + (16 * et + r) * TSTR + (32 * ks + 8 * q) * 2);
#pragma unroll
        for (int t = 0; t < 2; ++t) st[t] = mfma16(a, ldsr128(lds + RKD + (16 * (dt0 + t) + r) * TSTR + (32 * ks + 8 * q) * 2), st[t]);
    }
}
__device__ __forceinline__ void ret_chunk_out(lds8* lds, const bf16_t* __restrict__ proj, bf16_t* __restrict__ mix, size_t rowbase, int h, float lg2, int w, int r, int q) {
    const int l = 16 * w + r;
    const bf16x8 yq0 = ldsr128(lds + RQ + l * RSTR + 16 * q), yq1 = ldsr128(lds + RQ + l * RSTR + 16 * q + 64);
    lds8* prow = lds + RP + l * TSTR;
    for (int mt = 0; mt <= w; ++mt) {
        const lds8* kp = lds + RK + (16 * mt + r) * RSTR + 16 * q;
        f32x4 d = mfma16(ldsr128(kp), yq0, (f32x4){0.f, 0.f, 0.f, 0.f});
        d = mfma16(ldsr128(kp + 64), yq1, d);
        float pv[4];
#pragma unroll
        for (int i = 0; i < 4; ++i) { const int dl = l - (16 * mt + 4 * q + i); pv[i] = (dl >= 0) ? d[i] * exp2f(lg2 * (float)dl) : 0.f; }
        u32x2 v; v.x = pkbf(pv[0], pv[1]); v.y = pkbf(pv[2], pv[3]);
        ldsw64(prow + (16 * mt + 4 * q) * 2, v);
    }
    if ((w & 1) == 0) ldsw64(prow + (16 * (w + 1) + 4 * q) * 2, (u32x2){0u, 0u});
    const int nks = (w + 2) >> 1;
    f32x4 oi[4], oc[4];
#pragma unroll
    for (int et = 0; et < 4; ++et) { oi[et] = (f32x4){0.f, 0.f, 0.f, 0.f}; oc[et] = (f32x4){0.f, 0.f, 0.f, 0.f}; }
    for (int ks = 0; ks < nks; ++ks) {
        const bf16x8 yp = ldsr128(prow + (32 * ks + 8 * q) * 2);
#pragma unroll
        for (int et = 0; et < 4; ++et) oi[et] = mfma16(ldsr128(lds + RVT + (16 * et + r) * TSTR + (32 * ks + 8 * q) * 2), yp, oi[et]);
    }
#pragma unroll
    for (int et = 0; et < 4; ++et) {
        oc[et] = mfma16(ldsr128(lds + RST + (16 * et + r) * RSTR + 16 * q), yq0, oc[et]);
        oc[et] = mfma16(ldsr128(lds + RST + (16 * et + r) * RSTR + 16 * q + 64), yq1, oc[et]);
    }
    const float qd = exp2f(lg2 * (float)(l + 1));
    float ss = 0.f;
#pragma unroll
    for (int et = 0; et < 4; ++et) { oi[et] = oi[et] + oc[et] * qd; ss += (oi[et][0] * oi[et][0] + oi[et][1] * oi[et][1]) + (oi[et][2] * oi[et][2] + oi[et][3] * oi[et][3]); }
    ss += __shfl_xor(ss, 16); ss += __shfl_xor(ss, 32);
    const float rstd = 1.0f / sqrtf(ss * (1.f / 64.f) + EPS);
    const bf16_t* gp = proj + (rowbase + l) * INW + C_GR + h * 64 + 4 * q;
    bf16_t* op = mix + (rowbase + l) * 1024 + h * 64 + 4 * q;
#pragma unroll
    for (int et = 0; et < 4; ++et) {
        const u32x2 gr = *(const u32x2*)(gp + 16 * et);
        const float g0 = bflo(gr.x), g1 = bfhi(gr.x), g2 = bflo(gr.y), g3 = bfhi(gr.y);
        const float s0 = g0 / (1.f + __expf(-g0)), s1 = g1 / (1.f + __expf(-g1)), s2 = g2 / (1.f + __expf(-g2)), s3 = g3 / (1.f + __expf(-g3));
        u32x2 v; v.x = pkbf(oi[et][0] * rstd * s0, oi[et][1] * rstd * s1); v.y = pkbf(oi[et][2] * rstd * s2, oi[et][3] * rstd * s3);
        *(u32x2*)(op + 16 * et) = v;
    }
}
__device__ __forceinline__ float ret_lg2(int h) { return log2f(1.0f - exp2f(-5.0f - (float)h)); }
__device__ __forceinline__ void ret_u_item(lds8* lds, const bf16_t* __restrict__ proj, float* __restrict__ ust, int b, int h, int c) {
    const int tid = threadIdx.x, lane = tid & 63, w = __builtin_amdgcn_readfirstlane(tid >> 6), r = lane & 15, q = lane >> 4;
    ret_stage(lds, proj, (size_t)b * 2048 + 128 * c, h, ret_lg2(h), false);
    __syncthreads();
    f32x4 st[2]; st[0] = (f32x4){0.f, 0.f, 0.f, 0.f}; st[1] = (f32x4){0.f, 0.f, 0.f, 0.f};
    ret_state_update(lds, st, w, r, q, 0.f);
    float* up = ust + ((size_t)((b * 8 + h) * 16 + c) * 16 + w * 2) * 256 + lane * 4;
    *(f32x4*)up = st[0]; *(f32x4*)(up + 256) = st[1];
    __syncthreads();
}
__device__ __forceinline__ void ret_item(lds8* lds, const bf16_t* __restrict__ proj, bf16_t* __restrict__ mix, const float* __restrict__ ust, float* __restrict__ out, int b, int h, int qq) {
    const int tid = threadIdx.x, lane = tid & 63, w = __builtin_amdgcn_readfirstlane(tid >> 6), r = lane & 15, q = lane >> 4;
    const float lg2 = ret_lg2(h), g128 = exp2f(lg2 * 128.f);
    const int et = w >> 1, dt0 = 2 * (w & 1);
    f32x4 st[2]; st[0] = (f32x4){0.f, 0.f, 0.f, 0.f}; st[1] = (f32x4){0.f, 0.f, 0.f, 0.f};
    for (int j = 0; j < 4 * qq; ++j) {
        const float* up = ust + ((size_t)((b * 8 + h) * 16 + j) * 16 + w * 2) * 256 + lane * 4;
        st[0] = st[0] * g128 + *(const f32x4*)up; st[1] = st[1] * g128 + *(const f32x4*)(up + 256);
    }
    for (int cc = 0; cc < 4; ++cc) {
        const size_t rowbase = (size_t)b * 2048 + 128 * (4 * qq + cc);
#pragma unroll
        for (int t = 0; t < 2; ++t)
#pragma unroll
            for (int i = 0; i < 4; ++i) ldsw16(lds + RST + (16 * et + 4 * q + i) * RSTR + (16 * (dt0 + t) + r) * 2, pkbf(st[t][i], 0.f) & 0xffffu);
        ret_stage(lds, proj, rowbase, h, lg2, true);
        __syncthreads();
        ret_chunk_out(lds, proj, mix, rowbase, h, lg2, w, r, q);
        ret_state_update(lds, st, w, r, q, g128);
        __syncthreads();
    }
    if (qq == 3) {
#pragma unroll
        for (int t = 0; t < 2; ++t) *(f32x4*)(out + O_RETP + ((size_t)(b * 8 + h) * 64 + 16 * (dt0 + t) + r) * 64 + 16 * et + 4 * q) = st[t];
    }
}

__device__ __forceinline__ void sample_item(lds8* lds, const bf16_t* __restrict__ proj, bf16_t* __restrict__ mix, float* __restrict__ out, const float* __restrict__ state_ret,
                                            const float* __restrict__ cache_k, const float* __restrict__ cache_v, const float* __restrict__ qg, const float* __restrict__ kg, const float* __restrict__ sinks, int b) {
    const int tid = threadIdx.x, lane = tid & 63, w = __builtin_amdgcn_readfirstlane(tid >> 6);
    LAS float* Kf = (LAS float*)(lds);
    LAS float* Vf = (LAS float*)(lds + 35360);
    LAS float* Qf = (LAS float*)(lds + 70176);
    LAS float* Pf = (LAS float*)(lds + 78368);
    const size_t Rs = (size_t)MP + b * 8;
    for (int kvh = 0; kvh < 2; ++kvh) {
        __syncthreads();
        for (int idx = tid; idx < 2048; idx += 512) {
            const int j = idx >> 4, c4 = idx & 15;
            const size_t src = ((size_t)(b * 128 + j) * 2 + kvh) * 64 + c4 * 4;
            const f32x4 kv = *(const f32x4*)(cache_k + src), vv = *(const f32x4*)(cache_v + src);
            LAS float* kd = Kf + j * 65 + c4 * 4; kd[0] = kv[0]; kd[1] = kv[1]; kd[2] = kv[2]; kd[3] = kv[3];
            *(LAS f32x4*)(Vf + j * 64 + c4 * 4) = vv;
            if (j >= 8) { const size_t dst = ((size_t)(b * 128 + j - 8) * 2 + kvh) * 64 + c4 * 4; *(f32x4*)(out + O_KS + dst) = kv; *(f32x4*)(out + O_VS + dst) = vv; }
        }
        if (tid < 64) {
            const int i = tid >> 3, seg = tid & 7;
            const bf16_t* p = proj + (Rs + i) * INW + C_KS + kvh * 64 + seg * 8;
            float kf[8], vf[8]; unpack8(*(const u32x4*)p, kf); unpack8(*(const u32x4*)(p + 128), vf);
            float ss = 0.f;
#pragma unroll
            for (int e = 0; e < 8; ++e) ss += kf[e] * kf[e];
            ss += __shfl_xor(ss, 1); ss += __shfl_xor(ss, 2); ss += __shfl_xor(ss, 4);
            const float rstd = 1.0f / sqrtf(ss * (1.f / 64.f) + EPS);
            const size_t dst = ((size_t)(b * 128 + 120 + i) * 2 + kvh) * 64 + seg * 8;
#pragma unroll
            for (int e = 0; e < 8; ++e) { kf[e] *= rstd * kg[seg * 8 + e]; Kf[(128 + i) * 65 + seg * 8 + e] = kf[e]; Vf[(128 + i) * 64 + seg * 8 + e] = vf[e]; out[O_KS + dst + e] = kf[e]; out[O_VS + dst + e] = vf[e]; }
        } else if (tid < 320) {
            const int idx = tid - 64, rowq = idx >> 3, seg = idx & 7, g = rowq >> 3, i = rowq & 7;
            const bf16_t* p = proj + (Rs + i) * INW + C_QS + (kvh * 4 + g) * 64 + seg * 8;
            float qf[8]; unpack8(*(const u32x4*)p, qf);
            float ss = 0.f;
#pragma unroll
            for (int e = 0; e < 8; ++e) ss += qf[e] * qf[e];
            ss += __shfl_xor(ss, 1); ss += __shfl_xor(ss, 2); ss += __shfl_xor(ss, 4);
            const float rstd = 0.125f / sqrtf(ss * (1.f / 64.f) + EPS);
#pragma unroll
            for (int e = 0; e < 8; ++e) Qf[rowq * 64 + seg * 8 + e] = qf[e] * rstd * qg[seg * 8 + e];
        }
        __syncthreads();
        for (int rr = 0; rr < 4; ++rr) {
            const int rowq = 4 * w + rr, g = rowq >> 3, i = rowq & 7, head = kvh * 4 + g;
            const float slope = exp2f(-(float)(head + 1)), sink = sinks[head];
            float s[3];
#pragma unroll
            for (int t = 0; t < 3; ++t) {
                const int j = lane + 64 * t; float v = -1e30f;
                if (j < 136) {
                    float dot = 0.f;
#pragma unroll 16
                    for (int d = 0; d < 64; ++d) dot += Qf[rowq * 64 + d] * Kf[j * 65 + d];
                    const int dist = 128 + i - j;
                    if (dist >= 0 && dist < 128) v = dot - slope * (float)dist;
                }
                s[t] = v;
            }
            float mx = wave_max(fmaxf(fmaxf(s[0], s[1]), s[2])); mx = fmaxf(mx, sink);
            float p[3], sum = 0.f;
#pragma unroll
            for (int t = 0; t < 3; ++t) { p[t] = __expf(s[t] - mx); sum += p[t]; }
            sum = wave_sum(sum);
            const float inv = 1.0f / (sum + __expf(sink - mx));
#pragma unroll
            for (int t = 0; t < 3; ++t) { const int j = lane + 64 * t; if (j < 136) Pf[w * 136 + j] = p[t] * inv; }
            float o = 0.f;
#pragma unroll 8
            for (int j = 0; j < 136; ++j) o += Pf[w * 136 + j] * Vf[j * 64 + lane];
            mix[(Rs + i) * 1024 + 512 + head * 64 + lane] = (bf16_t)(pkbf(o, 0.f) & 0xffffu);
        }
    }
    __syncthreads();
    {
        const int h = w;
        LAS float* qf = (LAS float*)(lds + w * 4608); LAS float* kf = qf + 512; LAS float* scl = kf + 512;
        const float lg2 = ret_lg2(h);
        float v[8], gg[8];
#pragma unroll
        for (int l = 0; l < 8; ++l) {
            const bf16_t* p = proj + (Rs + l) * INW + h * 64 + lane;
            qf[l * 64 + lane] = bf2f(p[C_QR]); kf[l * 64 + lane] = 0.125f * bf2f(p[C_KR]); v[l] = bf2f(p[C_VR]); gg[l] = bf2f(p[C_GR]);
        }
        float S[64];
        const float* sp = state_ret + ((size_t)(b * 8 + h) * 64) * 64 + lane;
#pragma unroll
        for (int d = 0; d < 64; ++d) S[d] = sp[d * 64];
        {
            const int l = lane >> 3, m = lane & 7; float dot = 0.f;
#pragma unroll 16
            for (int d = 0; d < 64; ++d) dot += qf[l * 64 + d] * kf[m * 64 + d];
            scl[lane] = (m <= l) ? dot * exp2f(lg2 * (float)(l - m)) : 0.f;
        }
#pragma unroll
        for (int l = 0; l < 8; ++l) {
            float cross = 0.f, intra = 0.f;
#pragma unroll
            for (int d = 0; d < 64; ++d) cross += qf[l * 64 + d] * S[d];
#pragma unroll
            for (int m = 0; m < 8; ++m) intra += scl[l * 8 + m] * v[m];
            const float o = intra + exp2f(lg2 * (float)(l + 1)) * cross;
            const float ss = wave_sum(o * o);
            const float rstd = 1.0f / sqrtf(ss * (1.f / 64.f) + EPS);
            const float gl = gg[l], sil = gl / (1.f + __expf(-gl));
            mix[(Rs + l) * 1024 + h * 64 + lane] = (bf16_t)(pkbf(o * rstd * sil, 0.f) & 0xffffu);
        }
        const float g8 = exp2f(lg2 * 8.f);
        float vk[8];
#pragma unroll
        for (int m = 0; m < 8; ++m) vk[m] = v[m] * exp2f(lg2 * (float)(7 - m));
        float* op = out + O_RETS + ((size_t)(b * 8 + h) * 64) * 64 + lane;
#pragma unroll
        for (int d = 0; d < 64; ++d) {
            float acc = S[d] * g8;
#pragma unroll
            for (int m = 0; m < 8; ++m) acc += kf[m * 64 + d] * vk[m];
            op[d * 64] = acc;
        }
    }
    __syncthreads();
}

struct Args { const float* in[14]; float* out; unsigned char* ws; };
#ifndef PHM
#define PHM 0x7f
#endif
constexpr int SWA_HS = 2;
constexpr int NI_SWA = 8 * 16 * 2 * (4 / SWA_HS), NI_U = 8 * 8 * 15, NI_SMP = 128, NI_A = NI_SWA + NI_U + NI_SMP;

typedef const __attribute__((address_space(4))) Args* kargs_t;
__device__ __forceinline__ kargs_t argp() { kargs_t p = (kargs_t)__builtin_amdgcn_kernarg_segment_ptr(); asm volatile("" : "+s"(p)); return p; }

__global__ void __launch_bounds__(512, 2) fwd_kernel(Args a_unused) {
    extern __shared__ __attribute__((aligned(16))) unsigned char lds_raw[];
    lds8* lds = (lds8*)lds_raw;
    cg::grid_group grid = cg::this_grid();
    const int tid = threadIdx.x, lane = tid & 63, wave = __builtin_amdgcn_readfirstlane(tid >> 6);
    const int G = gridDim.x, bid = blockIdx.x;

    if (PHM & 1) {
        kargs_t ap = argp(); unsigned char* ws = ap->ws;
        LAS float* scr = (LAS float*)(lds + wave * 16384);
        const int gw = bid * 8 + wave, NGW = G * 8;
        constexpr int I_IN = (D / 64) * (INW / 32), I_OUT = (D / 64) * (D / 32), I_UP = (D / 64) * (FF / 32), I_DN = (FF / 64) * (D / 32);
        for (int it = gw; it < I_IN + I_OUT + I_UP + I_DN; it += NGW) {
            int r = it;
            if (r < I_IN) { transpose_item(ap->in[6], D, INW, (bf16_t*)(ws + WS_WIN), nullptr, scr, r, lane); continue; } r -= I_IN;
            if (r < I_OUT) { transpose_item(ap->in[10], D, D, (bf16_t*)(ws + WS_WOUT), nullptr, scr, r, lane); continue; } r -= I_OUT;
            if (r < I_UP) { transpose_item(ap->in[12], D, FF, (bf16_t*)(ws + WS_WUP), ap->in[11], scr, r, lane); continue; } r -= I_UP;
            transpose_item(ap->in[13], FF, D, (bf16_t*)(ws + WS_WDN), nullptr, scr, r, lane);
        }
        const float* x_prompt = ap->in[0]; const float* x_sample = ap->in[1]; const float* g_mix = ap->in[5];
        bf16_t* XN = (bf16_t*)(ws + WS_XN);
        for (int m = gw; m < M; m += NGW) {
            const float* xr = (m < MP) ? x_prompt + (size_t)m * D : x_sample + (size_t)(m - MP) * D;
            rms_row_to_bf16(xr, g_mix, XN + (size_t)m * D, lane);
        }
        float* rowss = (float*)(ws + WS_CTL);
        for (int i = bid * 512 + tid; i < M; i += G * 512) rowss[i] = 0.f;
    }
    grid.sync();

    if (PHM & 2) {
        kargs_t ap = argp(); unsigned char* ws = ap->ws;
        pg8::Gemm g{(const bf16_t*)(ws + WS_XN), (const bf16_t*)(ws + WS_WIN), M, INW, D}; pg8::StaticOrder S; S.init(M, INW, G, bid);
        pg8::EpiBf16<0> E{(bf16_t*)(ws + WS_PROJ), INW, nullptr};
        pg8::gemm_phase<pg8::EpiBf16<0>, pg8::StaticOrder, true, true>(lds, g, S, E);
    }
    grid.sync();

    if (PHM & 4) for (int it = bid; it < NI_A; it += G) {
        kargs_t ap = argp(); unsigned char* ws = ap->ws;
        const bf16_t* PROJ = (const bf16_t*)(ws + WS_PROJ);
        if (it < NI_SWA) {
            constexpr int HP = 4 / SWA_HS;
            const int hp = it % HP, kvh = (it / HP) & 1, n = (it / (2 * HP)) & 15, b = it / (32 * HP);
            swa_prompt_item(lds, PROJ, (bf16_t*)(ws + WS_MIX), ap->out, ap->in[7], ap->in[8], ap->in[9], b, n, kvh, hp * SWA_HS, SWA_HS);
        } else if (it < NI_SWA + NI_U) {
            const int r = it - NI_SWA, c = r % 15, h = (r / 15) & 7, b = r / 120;
            ret_u_item(lds, PROJ, (float*)(ws + WS_UST), b, h, c);
        } else {
            sample_item(lds, PROJ, (bf16_t*)(ws + WS_MIX), ap->out, ap->in[2], ap->in[3], ap->in[4], ap->in[7], ap->in[8], ap->in[9], it - NI_SWA - NI_U);
        }
    }
    grid.sync();

    if (PHM & 8) for (int it = bid; it < 256; it += G) {
        kargs_t ap = argp(); unsigned char* ws = ap->ws;
        ret_item(lds, (const bf16_t*)(ws + WS_PROJ), (bf16_t*)(ws + WS_MIX), (const float*)(ws + WS_UST), ap->out, it >> 5, (it >> 2) & 7, it & 3);
    }
    grid.sync();

    if (PHM & 16) {
        kargs_t ap = argp(); unsigned char* ws = ap->ws;
        pg8::Gemm g{(const bf16_t*)(ws + WS_MIX), (const bf16_t*)(ws + WS_WOUT), M, D, D}; pg8::StaticOrder S; S.init(M, D, G, bid);
        pg8::EpiRes E{ap->in[0], ap->in[1], ap->out, (bf16_t*)(ws + WS_XN), (float*)(ws + WS_CTL)};
        pg8::gemm_phase<pg8::EpiRes, pg8::StaticOrder, true, true>(lds, g, S, E);
    }
    grid.sync();

    if (PHM & 32) {
        kargs_t ap = argp(); unsigned char* ws = ap->ws;
        pg8::Gemm g{(const bf16_t*)(ws + WS_XN), (const bf16_t*)(ws + WS_WUP), M, FF, D}; pg8::StaticOrder S; S.init(M, FF, G, bid);
        pg8::EpiBf16<1> E{(bf16_t*)(ws + WS_U), FF, (const float*)(ws + WS_CTL)};
        pg8::gemm_phase<pg8::EpiBf16<1>, pg8::StaticOrder, true, true>(lds, g, S, E);
    }
    grid.sync();

    if (PHM & 64) {
        kargs_t ap = argp(); unsigned char* ws = ap->ws;
        pg8::Gemm g{(const bf16_t*)(ws + WS_U), (const bf16_t*)(ws + WS_WDN), M, D, FF}; pg8::StaticOrder S; S.init(M, D, G, bid);
        pg8::EpiDown E{ap->out};
        pg8::gemm_phase<pg8::EpiDown, pg8::StaticOrder, true, true>(lds, g, S, E);
    }
}

extern "C" void kernel_launch(void* const* d_in, const int* in_sizes, int n_in, void* d_out, int out_size, void* d_ws, size_t ws_size, hipStream_t stream) {
    static int grid = 0;
    if (grid == 0) {
        int dev = 0, cus = 0, per_cu = 0;
        (void)hipGetDevice(&dev);
        (void)hipDeviceGetAttribute(&cus, hipDeviceAttributeMultiprocessorCount, dev);
        if (hipFuncSetAttribute((const void*)fwd_kernel, hipFuncAttributeMaxDynamicSharedMemorySize, LDS_BYTES) != hipSuccess) fprintf(stderr, "kernel_launch: hipFuncSetAttribute failed\n");
        if (hipOccupancyMaxActiveBlocksPerMultiprocessor(&per_cu, (const void*)fwd_kernel, 512, LDS_BYTES) != hipSuccess || per_cu < 1) per_cu = 1;
        (void)hipGetLastError();
        if (cus <= 0) cus = 256;
        grid = cus * per_cu;
    }
    Args a{};
    for (int i = 0; i < 14; ++i) a.in[i] = (const float*)d_in[i];
    a.out = (float*)d_out; a.ws = (unsigned char*)d_ws;
    void* params[] = {&a};
    hipError_t e = hipLaunchCooperativeKernel((const void*)fwd_kernel, dim3(grid), dim3(512), params, LDS_BYTES, stream);
    if (e != hipSuccess) fprintf(stderr, "kernel_launch: cooperative launch failed: %s (grid %d)\n", hipGetErrorString(e), grid);
}
```

```cpp
#include <hip/hip_runtime.h>
#include <hip/hip_cooperative_groups.h>
#include <cstdio>
#include <cstdint>
namespace cg = cooperative_groups;
namespace pg8 {
#define PG8_LAS __attribute__((address_space(3)))
typedef unsigned short bf16_t;
typedef short bf16x8 __attribute__((ext_vector_type(8)));
typedef float f32x4 __attribute__((ext_vector_type(4)));
typedef unsigned u32x4 __attribute__((ext_vector_type(4)));
constexpr int BM = 256, BK = 64, HALF = 128, HTB = HALF * BK * 2  , STAGE_BYTES = 8 * HTB, NXCD = 8, WGM = 8;

__host__ __device__ __forceinline__ int lds_byte(int r, int c) { const int st = (r >> 4) * 2 + (c >> 5), rr = r & 15, cc = c & 31, ob = rr * 64 + cc * 2; return st * 1024 + (ob ^ (((ob >> 9) & 1) << 5)); }
__host__ __device__ __forceinline__ void stage_rc(int b, int& R, int& C) { const int st = b / 1024, sb = b % 1024, swz = sb ^ (((sb >> 9) & 1) << 5); R = (st >> 1) * 16 + swz / 64; C = (st & 1) * 32 + (swz % 64) / 2; }
__host__ __device__ __forceinline__ int perm32(int rho) { const int n = rho >> 4, i = rho & 15; return 8 * (i >> 2) + 4 * n + (i & 3); }

struct Unit { int pm, pn; };
struct Gemm { const bf16_t* A; const bf16_t* Bt; int M, N, K; };

struct StaticOrder {
    int nM, nN, nwg, G, c;
    __host__ __device__ void init(int M, int N, int G_, int c_) { nM = M / BM; nN = N / BM; nwg = nM * nN; G = G_; c = c_; }
    __host__ __device__ bool next(int i, Unit& u) const {
        const long L = (long)i * G + c; if (L >= nwg) return false;
        int wgid = (int)L; { const int q = nwg / NXCD, r = nwg % NXCD, xcd = wgid % NXCD, off = wgid / NXCD; wgid = (xcd < r ? xcd * (q + 1) : r * (q + 1) + (xcd - r) * q) + off; }
        const int nig = WGM * nN, gid = wgid / nig, fm = gid * WGM, gsz = (nM - fm) < WGM ? (nM - fm) : WGM;
        u.pm = fm + ((wgid % nig) % gsz); u.pn = (wgid % nig) / gsz; return true;
    }
    __device__ __forceinline__ void a_ready(const Unit&) const {}
    __device__ __forceinline__ void done(const Unit&) const {}
};

__device__ __forceinline__ unsigned cvt_pk_bf16(float lo, float hi) { unsigned r; asm volatile("v_cvt_pk_bf16_f32 %0, %1, %2" : "=v"(r) : "v"(lo), "v"(hi)); return r; }
typedef float f32x2 __attribute__((ext_vector_type(2)));
typedef unsigned u32x2 __attribute__((ext_vector_type(2)));
constexpr int MROWS_PROMPT = 16384;
constexpr float RMS_EPS = 1e-6f;

template <int MODE> struct EpiBf16 {
    static constexpr bool PERM = true, AFTER_DRAIN = false;
    bf16_t* O; int ldc; const float* rowss;
    __device__ __forceinline__ void operator()(const f32x4 (&acc)[2][2][4][2], const Unit& u, int wr, int wc, int fr, int fq) const {
        const int row0 = u.pm * BM + wr * 64 + fr, col0 = u.pn * BM + wc * 32 + 8 * fq;
#pragma unroll
        for (int ai = 0; ai < 2; ++ai)
#pragma unroll
            for (int m = 0; m < 4; ++m) {
                const int row = row0 + ai * HALF + m * 16;
                float sc = 1.f;
                if (MODE == 1) sc = __builtin_amdgcn_rsqf(rowss[row] * (1.0f / 1024.0f) + RMS_EPS);
                bf16_t* rowp = O + (size_t)row * ldc + col0;
#pragma unroll
                for (int bj = 0; bj < 2; ++bj) {
                    f32x4 v0 = acc[ai][bj][m][0], v1 = acc[ai][bj][m][1];
                    if (MODE == 1) {
                        v0 = v0 * sc; v1 = v1 * sc;
#pragma unroll
                        for (int e = 0; e < 4; ++e) { const float a = fmaxf(v0[e], 0.f), b = fmaxf(v1[e], 0.f); v0[e] = a * a; v1[e] = b * b; }
                    }
                    u32x4 w; w.x = cvt_pk_bf16(v0[0], v0[1]); w.y = cvt_pk_bf16(v0[2], v0[3]); w.z = cvt_pk_bf16(v1[0], v1[1]); w.w = cvt_pk_bf16(v1[2], v1[3]);
                    *(u32x4*)(rowp + bj * HALF) = w;
                }
            }
    }
};

struct EpiRes {
    static constexpr bool PERM = false, AFTER_DRAIN = false;
    const float* xp; const float* xs; float* out; bf16_t* hb; float* rowss;
    __device__ __forceinline__ void operator()(const f32x4 (&acc)[2][2][4][2], const Unit& u, int wr, int wc, int fr, int fq) const {
        const int row0 = u.pm * BM + wr * 64 + fr, col0 = u.pn * BM + wc * 32 + 4 * fq;
#pragma unroll
        for (int ai = 0; ai < 2; ++ai)
#pragma unroll
            for (int m = 0; m < 4; ++m) {
                const int row = row0 + ai * HALF + m * 16;
                const float* xrow = (row < MROWS_PROMPT) ? xp + (size_t)row * 1024 : xs + (size_t)(row - MROWS_PROMPT) * 1024;
                float ss = 0.f;
#pragma unroll
                for (int bj = 0; bj < 2; ++bj)
#pragma unroll
                    for (int n = 0; n < 2; ++n) {
                        const int col = col0 + bj * HALF + n * 16;
                        const f32x4 h = *(const f32x4*)(xrow + col) + acc[ai][bj][m][n];
                        *(f32x4*)(out + (size_t)row * 1024 + col) = h;
                        ss += (h[0] * h[0] + h[1] * h[1]) + (h[2] * h[2] + h[3] * h[3]);
                        u32x2 w; w.x = cvt_pk_bf16(h[0], h[1]); w.y = cvt_pk_bf16(h[2], h[3]);
                        *(u32x2*)(hb + (size_t)row * 1024 + col) = w;
                    }
                ss += __shfl_xor(ss, 16); ss += __shfl_xor(ss, 32);
                if (fq == 0) __hip_atomic_fetch_add(rowss + row, ss, __ATOMIC_RELAXED, __HIP_MEMORY_SCOPE_AGENT);
            }
    }
};

struct EpiDown {
    static constexpr bool PERM = false, AFTER_DRAIN = false;
    float* out;
    __device__ __forceinline__ void operator()(const f32x4 (&acc)[2][2][4][2], const Unit& u, int wr, int wc, int fr, int fq) const {
        const int row0 = u.pm * BM + wr * 64 + fr, col0 = u.pn * BM + wc * 32 + 4 * fq;
#pragma unroll
        for (int ai = 0; ai < 2; ++ai)
#pragma unroll
            for (int m = 0; m < 4; ++m) {
                float* orow = out + (size_t)(row0 + ai * HALF + m * 16) * 1024 + col0;
#pragma unroll
                for (int bj = 0; bj < 2; ++bj)
#pragma unroll
                    for (int n = 0; n < 2; ++n) { float* p = orow + bj * HALF + n * 16; *(f32x4*)p = *(const f32x4*)p + acc[ai][bj][m][n]; }
            }
    }
};
template <class Epi, class Sched, bool ALIGN_EPI = false, bool SP2 = false>
__device__ __forceinline__ void gemm_phase(PG8_LAS unsigned char* lds, const Gemm g, const Sched& S, const Epi& E) {
    const int tid = threadIdx.x, wid = __builtin_amdgcn_readfirstlane(tid >> 6), lane = tid & 63, wr = wid >> 2, wc = wid & 3, fr = lane & 15, fq = lane >> 4;
    const int K = g.K, nt = K / BK;
    unsigned voffA[2], voffB[2];
#pragma unroll
    for (int i = 0; i < 2; ++i) { int R, C; stage_rc(tid * 16 + i * 8192, R, C); const int Rb = Epi::PERM ? ((R & ~31) + perm32(R & 31)) : R;
        voffA[i] = (unsigned)(R * K + C) * 2u; voffB[i] = (unsigned)(Rb * K + C) * 2u; }
    const size_t kstep = (size_t)(BK * 2);
    const size_t hstep = (size_t)HALF * K * 2;
    const size_t tstep = 2 * hstep;
    const unsigned ldsw = (unsigned)wid * 1024u;
    const int aoff = lds_byte(wr * 64 + fr, fq * 8), boff = lds_byte(wc * 32 + fr, fq * 8);
#define PG8_SA(b, h) (((b) * 2 + (h)) * HTB)
#define PG8_SB(b, h) ((4 + (b) * 2 + (h)) * HTB)
#define PG8_STAGE(bufoff, gbase, voff) do { _Pragma("unroll") for (int _i = 0; _i < 2; ++_i) \
        __builtin_amdgcn_global_load_lds((const unsigned*)((const char*)(gbase) + (voff)[_i]), (PG8_LAS unsigned*)(lds + (bufoff) + ldsw + _i * 8192), 16, 0, 0); } while (0)
#define PG8_LDA(dst, b, h) do { _Pragma("unroll") for (int m = 0; m < 4; ++m) _Pragma("unroll") for (int k = 0; k < 2; ++k) dst[m][k] = *(const PG8_LAS bf16x8*)(lds + PG8_SA(b, h) + aoff + m * 2048 + k * 1024); } while (0)
#define PG8_LDB(dst, b, h) do { _Pragma("unroll") for (int n = 0; n < 2; ++n) _Pragma("unroll") for (int k = 0; k < 2; ++k) dst[n][k] = *(const PG8_LAS bf16x8*)(lds + PG8_SB(b, h) + boff + n * 2048 + k * 1024); } while (0)
#define PG8_MMA(ai, bj, At, Bt) do { __builtin_amdgcn_s_setprio(1); _Pragma("unroll") for (int m = 0; m < 4; ++m) _Pragma("unroll") for (int n = 0; n < 2; ++n) _Pragma("unroll") for (int k = 0; k < 2; ++k) \
        acc[ai][bj][m][n] = __builtin_amdgcn_mfma_f32_16x16x32_bf16(Bt[n][k], At[m][k], acc[ai][bj][m][n], 0, 0, 0); __builtin_amdgcn_s_setprio(0); } while (0)
#define PG8_WAIT_V(n) asm volatile("s_waitcnt vmcnt(" #n ")" ::: "memory")
#define PG8_WAIT_L(n) asm volatile("s_waitcnt lgkmcnt(" #n ")" ::: "memory")
#define PG8_BAR __builtin_amdgcn_s_barrier()
#define PG8_SCHED __builtin_amdgcn_sched_barrier(0)
    Unit cur, nxt; int ui = 0;
    if (!S.next(0, cur)) return;
    f32x4 acc[2][2][4][2];
#pragma unroll
    for (int a = 0; a < 2; ++a)
#pragma unroll
        for (int b = 0; b < 2; ++b)
#pragma unroll
            for (int m = 0; m < 4; ++m)
#pragma unroll
                for (int n = 0; n < 2; ++n) acc[a][b][m][n] = (f32x4){0.f, 0.f, 0.f, 0.f};
    bf16x8 At[4][2], B0[2][2], B1[2][2];
    const char* cA = (const char*)g.A + (size_t)cur.pm * tstep; const char* cB = (const char*)g.Bt + (size_t)cur.pn * tstep;
    S.a_ready(cur);
    if constexpr (SP2) {
        PG8_STAGE(PG8_SB(0, 0), cB, voffB); PG8_STAGE(PG8_SB(0, 1), cB + hstep, voffB); PG8_STAGE(PG8_SA(0, 0), cA, voffA); PG8_STAGE(PG8_SA(0, 1), cA + hstep, voffA);
        if (wr == 1) PG8_BAR;
        PG8_WAIT_V(2); PG8_BAR;
        PG8_STAGE(PG8_SB(1, 0), cB + kstep, voffB); PG8_STAGE(PG8_SA(1, 0), cA + kstep, voffA); PG8_STAGE(PG8_SB(1, 1), cB + hstep + kstep, voffB);
        PG8_WAIT_V(6); PG8_BAR;
    } else {
        PG8_STAGE(PG8_SB(0, 0), cB, voffB); PG8_STAGE(PG8_SA(0, 0), cA, voffA); PG8_STAGE(PG8_SB(0, 1), cB + hstep, voffB); PG8_STAGE(PG8_SA(0, 1), cA + hstep, voffA);
        if (wr == 1) PG8_BAR;
        PG8_WAIT_V(4); PG8_BAR;
        PG8_STAGE(PG8_SB(1, 0), cB + kstep, voffB); PG8_STAGE(PG8_SA(1, 0), cA + kstep, voffA); PG8_STAGE(PG8_SB(1, 1), cB + hstep + kstep, voffB);
        PG8_WAIT_V(6); PG8_BAR;
    }
    for (;;) {
        const bool has_next = S.next(ui + 1, nxt);
        const char* nA = has_next ? (const char*)g.A + (size_t)nxt.pm * tstep : cA; const char* nB = has_next ? (const char*)g.Bt + (size_t)nxt.pn * tstep : cB;
        for (int t = 0; t < nt; t += 2) {
            const bool last = (t == nt - 2);
            const char* a1 = cA + (size_t)(t + 1) * kstep;
            const char* a2 = last ? nA : cA + (size_t)(t + 2) * kstep; const char* b2 = last ? nB : cB + (size_t)(t + 2) * kstep;
            const char* a3 = a2 + kstep; const char* b3 = b2 + kstep;
            if (last && has_next) S.a_ready(nxt);
            if constexpr (SP2) {
            PG8_LDB(B0, 0, 0); PG8_LDB(B1, 0, 1); PG8_SCHED; PG8_LDA(At, 0, 0); PG8_STAGE(PG8_SA(1, 1), a1 + hstep, voffA);
            PG8_WAIT_V(8); PG8_WAIT_L(0); PG8_BAR; PG8_MMA(0, 0, At, B0); PG8_MMA(0, 1, At, B1); PG8_BAR; PG8_SCHED;
            PG8_LDA(At, 0, 1); PG8_STAGE(PG8_SB(0, 0), b2, voffB); PG8_STAGE(PG8_SB(0, 1), b2 + hstep, voffB); PG8_STAGE(PG8_SA(0, 0), a2, voffA);
            PG8_WAIT_V(8); PG8_WAIT_L(0); PG8_BAR; PG8_MMA(1, 0, At, B0); PG8_MMA(1, 1, At, B1); PG8_BAR; PG8_SCHED;
            PG8_LDB(B0, 1, 0); PG8_LDB(B1, 1, 1); PG8_SCHED; PG8_LDA(At, 1, 0); PG8_STAGE(PG8_SA(0, 1), a2 + hstep, voffA);
            PG8_WAIT_V(8); PG8_WAIT_L(0); PG8_BAR; PG8_MMA(0, 0, At, B0); PG8_MMA(0, 1, At, B1); PG8_BAR; PG8_SCHED;
            PG8_LDA(At, 1, 1); PG8_STAGE(PG8_SB(1, 0), b3, voffB); PG8_STAGE(PG8_SB(1, 1), b3 + hstep, voffB); PG8_STAGE(PG8_SA(1, 0), a3, voffA);
            PG8_WAIT_V(8); PG8_WAIT_L(0); PG8_BAR; PG8_MMA(1, 0, At, B0); PG8_MMA(1, 1, At, B1); PG8_BAR; PG8_SCHED;
            } else {
            PG8_LDB(B0, 0, 0); PG8_SCHED; PG8_LDA(At, 0, 0); PG8_STAGE(PG8_SA(1, 1), a1 + hstep, voffA);
            PG8_WAIT_L(8); PG8_BAR; PG8_WAIT_L(0); PG8_MMA(0, 0, At, B0); PG8_BAR; PG8_SCHED;
            PG8_LDB(B1, 0, 1); PG8_STAGE(PG8_SB(0, 0), b2, voffB);
            PG8_BAR; PG8_WAIT_L(0); PG8_MMA(0, 1, At, B1); PG8_BAR;
            PG8_LDA(At, 0, 1); PG8_STAGE(PG8_SA(0, 0), a2, voffA);
            PG8_BAR; PG8_WAIT_L(0); PG8_MMA(1, 0, At, B0); PG8_BAR; PG8_SCHED;
            PG8_STAGE(PG8_SB(0, 1), b2 + hstep, voffB);
            PG8_WAIT_V(6); PG8_BAR; PG8_MMA(1, 1, At, B1); PG8_BAR;
            PG8_LDB(B0, 1, 0); PG8_SCHED; PG8_LDA(At, 1, 0); PG8_STAGE(PG8_SA(0, 1), a2 + hstep, voffA);
            PG8_WAIT_L(8); PG8_BAR; PG8_WAIT_L(0); PG8_MMA(0, 0, At, B0); PG8_BAR; PG8_SCHED;
            PG8_LDB(B1, 1, 1); PG8_STAGE(PG8_SB(1, 0), b3, voffB);
            PG8_BAR; PG8_WAIT_L(0); PG8_MMA(0, 1, At, B1); PG8_BAR;
            PG8_LDA(At, 1, 1); PG8_STAGE(PG8_SA(1, 0), a3, voffA);
            PG8_BAR; PG8_WAIT_L(0); PG8_MMA(1, 0, At, B0); PG8_BAR; PG8_SCHED;
            PG8_STAGE(PG8_SB(1, 1), b3 + hstep, voffB);
            PG8_WAIT_V(6); PG8_BAR; PG8_MMA(1, 1, At, B1); PG8_BAR;
            }
        }
        if constexpr (ALIGN_EPI) { if (wr == 0) PG8_BAR; }
        if constexpr (!Epi::AFTER_DRAIN) { E(acc, cur, wr, wc, fr, fq); S.done(cur); }
        if (!has_next) break;
#pragma unroll
        for (int a = 0; a < 2; ++a)
#pragma unroll
            for (int b = 0; b < 2; ++b)
#pragma unroll
                for (int m = 0; m < 4; ++m)
#pragma unroll
                    for (int n = 0; n < 2; ++n) acc[a][b][m][n] = (f32x4){0.f, 0.f, 0.f, 0.f};
        cur = nxt; cA = nA; cB = nB; ++ui;
        if constexpr (ALIGN_EPI) { if (wr == 1) PG8_BAR; }
    }
    PG8_WAIT_V(0);
    if constexpr (!ALIGN_EPI) { if (wr == 0) PG8_BAR; }
    PG8_BAR;
    if constexpr (Epi::AFTER_DRAIN) { E.fused(acc, cur, wr, wc, fr, fq, lds, wid, lane); S.done(cur); }
#undef PG8_SA
#undef PG8_SB
#undef PG8_STAGE
#undef PG8_LDA
#undef PG8_LDB
#undef PG8_MMA
#undef PG8_WAIT_V
#undef PG8_WAIT_L
#undef PG8_BAR
#undef PG8_SCHED
}
}
#define LAS __attribute__((address_space(3)))
typedef unsigned short bf16_t;
typedef short bf16x8 __attribute__((ext_vector_type(8)));
typedef float f32x4 __attribute__((ext_vector_type(4)));
typedef unsigned u32x4 __attribute__((ext_vector_type(4)));
typedef unsigned u32x2 __attribute__((ext_vector_type(2)));
typedef LAS unsigned char lds8;

constexpr int D = 1024, INW = 2816, FF = 4096;
constexpr int MP = 16384, MS = 1024, M = MP + MS;
constexpr int C_QR = 0, C_KR = 512, C_VR = 1024, C_GR = 1536, C_QS = 2048, C_KS = 2560, C_VS = 2688;
constexpr size_t O_RETP = 17825792, O_KP = 18087936, O_VP = 18219008, O_RETS = 18350080, O_KS = 22544384, O_VS = 24641536;
constexpr size_t MiB = 1u << 20;
constexpr size_t WS_CTL = 0, WS_WIN = 1 * MiB, WS_WOUT = 7 * MiB, WS_WUP = 9 * MiB, WS_WDN = 17 * MiB;
constexpr size_t WS_XN = 25 * MiB;
constexpr size_t WS_PROJ = 59 * MiB;
constexpr size_t WS_MIX = 153 * MiB;
constexpr size_t WS_U = 59 * MiB;
constexpr size_t WS_UST = 196 * MiB;
constexpr size_t WS_BAR = 131072;
constexpr int LDS_BYTES = 147456;
constexpr float EPS = 1e-6f, LOG2E = 1.4426950408889634f;

__device__ __forceinline__ unsigned pkbf(float lo, float hi) { return pg8::cvt_pk_bf16(lo, hi); }
__device__ __forceinline__ float bflo(unsigned u) { return __uint_as_float(u << 16); }
__device__ __forceinline__ float bfhi(unsigned u) { return __uint_as_float(u & 0xffff0000u); }
__device__ __forceinline__ float bf2f(bf16_t h) { return __uint_as_float((unsigned)h << 16); }
__device__ __forceinline__ void unpack8(const u32x4 v, float (&f)[8]) { f[0] = bflo(v.x); f[1] = bfhi(v.x); f[2] = bflo(v.y); f[3] = bfhi(v.y); f[4] = bflo(v.z); f[5] = bfhi(v.z); f[6] = bflo(v.w); f[7] = bfhi(v.w); }
__device__ __forceinline__ u32x4 pack8(const float (&f)[8]) { u32x4 o; o.x = pkbf(f[0], f[1]); o.y = pkbf(f[2], f[3]); o.z = pkbf(f[4], f[5]); o.w = pkbf(f[6], f[7]); return o; }
__device__ __forceinline__ bf16x8 ldsr128(const lds8* p) { return *(const LAS bf16x8*)p; }
__device__ __forceinline__ void ldsw128(lds8* p, u32x4 v) { *(LAS u32x4*)p = v; }
__device__ __forceinline__ void ldsw64(lds8* p, u32x2 v) { *(LAS u32x2*)p = v; }
__device__ __forceinline__ void ldsw16(lds8* p, unsigned v) { *(LAS unsigned short*)p = (unsigned short)v; }
__device__ __forceinline__ f32x4 mfma16(bf16x8 a, bf16x8 b, f32x4 c) { return __builtin_amdgcn_mfma_f32_16x16x32_bf16(a, b, c, 0, 0, 0); }
__device__ __forceinline__ float wave_sum(float v) {
#pragma unroll
    for (int o = 1; o < 64; o <<= 1) v += __shfl_xor(v, o);
    return v;
}
__device__ __forceinline__ float wave_max(float v) {
#pragma unroll
    for (int o = 1; o < 64; o <<= 1) v = fmaxf(v, __shfl_xor(v, o));
    return v;
}
__device__ __forceinline__ float ex2(float x) { return __builtin_amdgcn_exp2f(x); }

__device__ __forceinline__ void transpose_item(const float* __restrict__ W, int K, int N, bf16_t* __restrict__ WT, const float* __restrict__ gain, LAS float* scr, int item, int lane) {
    const int nblk = N / 32, kb = item / nblk, nb = item % nblk, k0 = 64 * kb, n0 = 32 * nb;
#pragma unroll 8
    for (int i = 0; i < 32; ++i) { const int kk = 2 * i + (lane >> 5); const float g = gain ? gain[k0 + kk] : 1.f; scr[kk * 33 + (lane & 31)] = W[(size_t)(k0 + kk) * N + n0 + (lane & 31)] * g; }
    asm volatile("s_waitcnt lgkmcnt(0)" ::: "memory");
    const int c = lane & 7;
#pragma unroll
    for (int j = 0; j < 4; ++j) { const int n = (lane >> 3) + 8 * j; const LAS float* s = scr + (8 * c) * 33 + n;
        u32x4 o; o.x = pkbf(s[0 * 33], s[1 * 33]); o.y = pkbf(s[2 * 33], s[3 * 33]); o.z = pkbf(s[4 * 33], s[5 * 33]); o.w = pkbf(s[6 * 33], s[7 * 33]);
        *(u32x4*)(WT + (size_t)(n0 + n) * K + k0 + 8 * c) = o; }
    asm volatile("s_waitcnt lgkmcnt(0)" ::: "memory");
}
__device__ __forceinline__ void rms_row_to_bf16(const float* __restrict__ xrow, const float* __restrict__ gain, bf16_t* __restrict__ orow, int lane) {
    const f32x4* xr = (const f32x4*)xrow + lane; const f32x4* gr = (const f32x4*)gain + lane;
    f32x4 v[4]; float s = 0.f;
#pragma unroll
    for (int j = 0; j < 4; ++j) { v[j] = xr[64 * j]; s += (v[j].x * v[j].x + v[j].y * v[j].y) + (v[j].z * v[j].z + v[j].w * v[j].w); }
    const float rstd = 1.0f / sqrtf(wave_sum(s) * (1.f / D) + EPS);
    u32x2* o8 = (u32x2*)orow + lane;
#pragma unroll
    for (int j = 0; j < 4; ++j) { const f32x4 g = gr[64 * j]; u32x2 o; o.x = pkbf(v[j].x * rstd * g.x, v[j].y * rstd * g.y); o.y = pkbf(v[j].z * rstd * g.z, v[j].w * rstd * g.w); o8[64 * j] = o; }
}

__device__ __forceinline__ void swa_prompt_item(lds8* lds, const bf16_t* __restrict__ proj, bf16_t* __restrict__ mix, float* __restrict__ out,
                                                const float* __restrict__ qg, const float* __restrict__ kg, const float* __restrict__ sinks, int b, int n, int kvh, int h0, int nh) {
    const int tid = threadIdx.x, lane = tid & 63, w = __builtin_amdgcn_readfirstlane(tid >> 6), r = lane & 15, q = lane >> 4;
    constexpr int KS = 0, KSTR = 144, VT = 36864, VSTR = 528, QS = 70656, QSTR = 144, PS = 89088, PSTR = 336, PWAVE = 5376;
    const size_t rowb = (size_t)b * 2048;
    for (int idx = tid; idx < 2048; idx += 512) {
        const int row = idx >> 3, seg = idx & 7, t = (n - 1) * 128 + row;
        float kf[8]; u32x4 vr = (u32x4){0u, 0u, 0u, 0u};
        if (t >= 0) { const bf16_t* p = proj + (rowb + t) * INW + C_KS + kvh * 64 + seg * 8; const u32x4 kr = *(const u32x4*)p; vr = *(const u32x4*)(p + 128); unpack8(kr, kf); }
        else {
#pragma unroll
            for (int e = 0; e < 8; ++e) kf[e] = 0.f; }
        float ss = 0.f;
#pragma unroll
        for (int e = 0; e < 8; ++e) ss += kf[e] * kf[e];
        ss += __shfl_xor(ss, 1); ss += __shfl_xor(ss, 2); ss += __shfl_xor(ss, 4);
        const float rstd = 1.0f / sqrtf(ss * (1.f / 64.f) + EPS);
#pragma unroll
        for (int e = 0; e < 8; ++e) kf[e] *= rstd * kg[seg * 8 + e];
        ldsw128(lds + KS + row * KSTR + seg * 16, pack8(kf));
        lds8* vt = lds + VT + (seg * 8) * VSTR + row * 2;
        ldsw16(vt + 0 * VSTR, vr.x & 0xffffu); ldsw16(vt + 1 * VSTR, vr.x >> 16); ldsw16(vt + 2 * VSTR, vr.y & 0xffffu); ldsw16(vt + 3 * VSTR, vr.y >> 16);
        ldsw16(vt + 4 * VSTR, vr.z & 0xffffu); ldsw16(vt + 5 * VSTR, vr.z >> 16); ldsw16(vt + 6 * VSTR, vr.w & 0xffffu); ldsw16(vt + 7 * VSTR, vr.w >> 16);
        if (n == 15 && h0 == 0 && row >= 128) {
            const size_t dst = ((size_t)(b * 128 + row - 128) * 2 + kvh) * 64 + seg * 8;
            float vf[8]; unpack8(vr, vf);
            *(f32x4*)(out + O_KP + dst) = (f32x4){kf[0], kf[1], kf[2], kf[3]}; *(f32x4*)(out + O_KP + dst + 4) = (f32x4){kf[4], kf[5], kf[6], kf[7]};
            *(f32x4*)(out + O_VP + dst) = (f32x4){vf[0], vf[1], vf[2], vf[3]}; *(f32x4*)(out + O_VP + dst + 4) = (f32x4){vf[4], vf[5], vf[6], vf[7]};
        }
    }
    for (int hh = h0; hh < h0 + nh; ++hh) {
        const int head = kvh * 4 + hh;
        __syncthreads();
        for (int idx = tid; idx < 1024; idx += 512) {
            const int row = idx >> 3, seg = idx & 7;
            const bf16_t* p = proj + (rowb + n * 128 + row) * INW + C_QS + head * 64 + seg * 8;
            float qf[8]; unpack8(*(const u32x4*)p, qf);
            float ss = 0.f;
#pragma unroll
            for (int e = 0; e < 8; ++e) ss += qf[e] * qf[e];
            ss += __shfl_xor(ss, 1); ss += __shfl_xor(ss, 2); ss += __shfl_xor(ss, 4);
            const float rstd = (0.125f * LOG2E) / sqrtf(ss * (1.f / 64.f) + EPS);
#pragma unroll
            for (int e = 0; e < 8; ++e) qf[e] *= rstd * qg[seg * 8 + e];
            ldsw128(lds + QS + row * QSTR + seg * 16, pack8(qf));
        }
        __syncthreads();
        const float slope2 = exp2f(-(float)(head + 1)) * LOG2E, sink2 = sinks[head] * LOG2E;
        const bf16x8 yq0 = ldsr128(lds + QS + (16 * w + r) * QSTR + 16 * q), yq1 = ldsr128(lds + QS + (16 * w + r) * QSTR + 16 * q + 64);
        f32x4 sc[9];
#pragma unroll
        for (int j = 0; j < 9; ++j) {
            const lds8* kp = lds + KS + (16 * (w + j) + r) * KSTR + 16 * q;
            sc[j] = mfma16(ldsr128(kp), yq0, (f32x4){0.f, 0.f, 0.f, 0.f});
            sc[j] = mfma16(ldsr128(kp + 64), yq1, sc[j]);
        }
        const int qi = 16 * w + r;
        float mx = sink2;
#pragma unroll
        for (int j = 0; j < 9; ++j)
#pragma unroll
            for (int i = 0; i < 4; ++i) {
                const int key = 16 * (w + j) + 4 * q + i, dist = 128 + qi - key;
                const bool valid = (dist >= 0) && (dist < 128) && (n > 0 || key >= 128);
                const float v = valid ? sc[j][i] - slope2 * (float)dist : -1e30f;
                sc[j][i] = v; mx = fmaxf(mx, v);
            }
        mx = fmaxf(mx, __shfl_xor(mx, 16)); mx = fmaxf(mx, __shfl_xor(mx, 32));
        float sum = 0.f;
#pragma unroll
        for (int j = 0; j < 9; ++j)
#pragma unroll
            for (int i = 0; i < 4; ++i) { const float p = ex2(sc[j][i] - mx); sc[j][i] = p; sum += p; }
        sum += __shfl_xor(sum, 16); sum += __shfl_xor(sum, 32);
        const float inv = 1.0f / (sum + ex2(sink2 - mx));
        lds8* pw = lds + PS + w * PWAVE + r * PSTR;
#pragma unroll
        for (int j = 0; j < 9; ++j) { const int slot = j + (w & 1); u32x2 v; v.x = pkbf(sc[j][0] * inv, sc[j][1] * inv); v.y = pkbf(sc[j][2] * inv, sc[j][3] * inv); ldsw64(pw + (slot * 16 + 4 * q) * 2, v); }
        { const int zs = (w & 1) ? 0 : 9; ldsw64(pw + (zs * 16 + 4 * q) * 2, (u32x2){0u, 0u}); }
        f32x4 o[4];
#pragma unroll
        for (int et = 0; et < 4; ++et) o[et] = (f32x4){0.f, 0.f, 0.f, 0.f};
        const int s0 = 16 * (w & ~1);
#pragma unroll
        for (int ks = 0; ks < 5; ++ks) {
            const bf16x8 yp = ldsr128(pw + (32 * ks + 8 * q) * 2);
#pragma unroll
            for (int et = 0; et < 4; ++et) o[et] = mfma16(ldsr128(lds + VT + (16 * et + r) * VSTR + (s0 + 32 * ks + 8 * q) * 2), yp, o[et]);
        }
        bf16_t* op = mix + (rowb + n * 128 + qi) * 1024 + 512 + head * 64 + 4 * q;
#pragma unroll
        for (int et = 0; et < 4; ++et) { u32x2 v; v.x = pkbf(o[et][0], o[et][1]); v.y = pkbf(o[et][2], o[et][3]); *(u32x2*)(op + 16 * et) = v; }
    }
    __syncthreads();
}

constexpr int RQ = 0, RK = 18432, RVT = 36864, RKD = 54272, RP = 71680, RST = 106496, RSTR = 144, TSTR = 272;
__device__ __forceinline__ void ret_stage(lds8* lds, const bf16_t* __restrict__ proj, size_t rowbase, int h, float lg2, bool full) {
    const int tid = threadIdx.x;
    for (int idx = tid; idx < 1024; idx += 512) {
        const int row = idx >> 3, seg = idx & 7;
        const bf16_t* p = proj + (rowbase + row) * INW + h * 64 + seg * 8;
        const u32x4 kr = *(const u32x4*)(p + C_KR), vr = *(const u32x4*)(p + C_VR);
        float kf[8]; unpack8(kr, kf);
        const float kd = exp2f(lg2 * (float)(127 - row)) * 0.125f;
        lds8* kt = lds + RKD + (seg * 8) * TSTR + row * 2;
#pragma unroll
        for (int e = 0; e < 8; e += 2) { const unsigned pk = pkbf(kf[e] * kd, kf[e + 1] * kd); ldsw16(kt + e * TSTR, pk & 0xffffu); ldsw16(kt + (e + 1) * TSTR, pk >> 16); }
        lds8* vt = lds + RVT + (seg * 8) * TSTR + row * 2;
        ldsw16(vt + 0 * TSTR, vr.x & 0xffffu); ldsw16(vt + 1 * TSTR, vr.x >> 16); ldsw16(vt + 2 * TSTR, vr.y & 0xffffu); ldsw16(vt + 3 * TSTR, vr.y >> 16);
        ldsw16(vt + 4 * TSTR, vr.z & 0xffffu); ldsw16(vt + 5 * TSTR, vr.z >> 16); ldsw16(vt + 6 * TSTR, vr.w & 0xffffu); ldsw16(vt + 7 * TSTR, vr.w >> 16);
        if (full) {
#pragma unroll
            for (int e = 0; e < 8; ++e) kf[e] *= 0.125f;
            ldsw128(lds + RK + row * RSTR + seg * 16, pack8(kf));
            ldsw128(lds + RQ + row * RSTR + seg * 16, *(const u32x4*)(p + C_QR));
        }
    }
}
__device__ __forceinline__ void ret_state_update(const lds8* lds, f32x4 (&st)[2], int w, int r, int q, float dec) {
    const int et = w >> 1, dt0 = 2 * (w & 1);
    st[0] = st[0] * dec; st[1] = st[1] * dec;
#pragma unroll
    for (int ks = 0; ks < 4; ++ks) {
        const bf16x8 a = ldsr128(lds + RVT + (16 * et + r) * TSTR + (32 * ks + 8 * q) * 2);
#pragma unroll
        for (int t = 0; t < 2; ++t) st[t] = mfma16(a, ldsr128(lds + RKD + (16 * (dt0 + t) + r) * TSTR + (32 * ks + 8 * q) * 2), st[t]);
    }
}
__device__ __forceinline__ void ret_chunk_out(lds8* lds, const bf16_t* __restrict__ proj, bf16_t* __restrict__ mix, size_t rowbase, int h, float lg2, int w, int r, int q) {
    const int l = 16 * w + r;
    const bf16x8 yq0 = ldsr128(lds + RQ + l * RSTR + 16 * q), yq1 = ldsr128(lds + RQ + l * RSTR + 16 * q + 64);
    lds8* prow = lds + RP + l * TSTR;
    for (int mt = 0; mt <= w; ++mt) {
        const lds8* kp = lds + RK + (16 * mt + r) * RSTR + 16 * q;
        f32x4 d = mfma16(ldsr128(kp), yq0, (f32x4){0.f, 0.f, 0.f, 0.f});
        d = mfma16(ldsr128(kp + 64), yq1, d);
        float pv[4];
#pragma unroll
        for (int i = 0; i < 4; ++i) { const int dl = l - (16 * mt + 4 * q + i); pv[i] = (dl >= 0) ? d[i] * exp2f(lg2 * (float)dl) : 0.f; }
        u32x2 v; v.x = pkbf(pv[0], pv[1]); v.y = pkbf(pv[2], pv[3]);
        ldsw64(prow + (16 * mt + 4 * q) * 2, v);
    }
    if ((w & 1) == 0) ldsw64(prow + (16 * (w + 1) + 4 * q) * 2, (u32x2){0u, 0u});
    const int nks = (w + 2) >> 1;
    f32x4 oi[4], oc[4];
#pragma unroll
    for (int et = 0; et < 4; ++et) { oi[et] = (f32x4){0.f, 0.f, 0.f, 0.f}; oc[et] = (f32x4){0.f, 0.f, 0.f, 0.f}; }
    for (int ks = 0; ks < nks; ++ks) {
        const bf16x8 yp = ldsr128(prow + (32 * ks + 8 * q) * 2);
#pragma unroll
        for (int et = 0; et < 4; ++et) oi[et] = mfma16(ldsr128(lds + RVT + (16 * et + r) * TSTR + (32 * ks + 8 * q) * 2), yp, oi[et]);
    }
#pragma unroll
    for (int et = 0; et < 4; ++et) {
        oc[et] = mfma16(ldsr128(lds + RST + (16 * et + r) * RSTR + 16 * q), yq0, oc[et]);
        oc[et] = mfma16(ldsr128(lds + RST + (16 * et + r) * RSTR + 16 * q + 64), yq1, oc[et]);
    }
    const float qd = exp2f(lg2 * (float)(l + 1));
    float ss = 0.f;
#pragma unroll
    for (int et = 0; et < 4; ++et) { oi[et] = oi[et] + oc[et] * qd; ss += (oi[et][0] * oi[et][0] + oi[et][1] * oi[et][1]) + (oi[et][2] * oi[et][2] + oi[et][3] * oi[et][3]); }
    ss += __shfl_xor(ss, 16); ss += __shfl_xor(ss, 32);
    const float rstd = 1.0f / sqrtf(ss * (1.f / 64.f) + EPS);
    const bf16_t* gp = proj + (rowbase + l) * INW + C_GR + h * 64 + 4 * q;
    bf16_t* op = mix + (rowbase + l) * 1024 + h * 64 + 4 * q;
#pragma unroll
    for (int et = 0; et < 4; ++et) {
        const u32x2 gr = *(const u32x2*)(gp + 16 * et);
        const float g0 = bflo(gr.x), g1 = bfhi(gr.x), g2 = bflo(gr.y), g3 = bfhi(gr.y);
        const float s0 = g0 / (1.f + __expf(-g0)), s1 = g1 / (1.f + __expf(-g1)), s2 = g2 / (1.f + __expf(-g2)), s3 = g3 / (1.f + __expf(-g3));
        u32x2 v; v.x = pkbf(oi[et][0] * rstd * s0, oi[et][1] * rstd * s1); v.y = pkbf(oi[et][2] * rstd * s2, oi[et][3] * rstd * s3);
        *(u32x2*)(op + 16 * et) = v;
    }
}
__device__ __forceinline__ float ret_lg2(int h) { return log2f(1.0f - exp2f(-5.0f - (float)h)); }
__device__ __forceinline__ void ret_u_item(lds8* lds, const bf16_t* __restrict__ proj, float* __restrict__ ust, int b, int h, int c) {
    const int tid = threadIdx.x, lane = tid & 63, w = __builtin_amdgcn_readfirstlane(tid >> 6), r = lane & 15, q = lane >> 4;
    ret_stage(lds, proj, (size_t)b * 2048 + 128 * c, h, ret_lg2(h), false);
    __syncthreads();
    f32x4 st[2]; st[0] = (f32x4){0.f, 0.f, 0.f, 0.f}; st[1] = (f32x4){0.f, 0.f, 0.f, 0.f};
    ret_state_update(lds, st, w, r, q, 0.f);
    float* up = ust + ((size_t)((b * 8 + h) * 16 + c) * 16 + w * 2) * 256 + lane * 4;
    *(f32x4*)up = st[0]; *(f32x4*)(up + 256) = st[1];
    __syncthreads();
}
__device__ __forceinline__ void ret_item(lds8* lds, const bf16_t* __restrict__ proj, bf16_t* __restrict__ mix, const float* __restrict__ ust, float* __restrict__ out, int b, int h, int qq) {
    const int tid = threadIdx.x, lane = tid & 63, w = __builtin_amdgcn_readfirstlane(tid >> 6), r = lane & 15, q = lane >> 4;
    const float lg2 = ret_lg2(h), g128 = exp2f(lg2 * 128.f);
    const int et = w >> 1, dt0 = 2 * (w & 1);
    f32x4 st[2]; st[0] = (f32x4){0.f, 0.f, 0.f, 0.f}; st[1] = (f32x4){0.f, 0.f, 0.f, 0.f};
    for (int j = 0; j < 4 * qq; ++j) {
        const float* up = ust + ((size_t)((b * 8 + h) * 16 + j) * 16 + w * 2) * 256 + lane * 4;
        st[0] = st[0] * g128 + *(const f32x4*)up; st[1] = st[1] * g128 + *(const f32x4*)(up + 256);
    }
    for (int cc = 0; cc < 4; ++cc) {
        const size_t rowbase = (size_t)b * 2048 + 128 * (4 * qq + cc);
#pragma unroll
        for (int t = 0; t < 2; ++t)
#pragma unroll
            for (int i = 0; i < 4; ++i) ldsw16(lds + RST + (16 * et + 4 * q + i) * RSTR + (16 * (dt0 + t) + r) * 2, pkbf(st[t][i], 0.f) & 0xffffu);
        ret_stage(lds, proj, rowbase, h, lg2, true);
        __syncthreads();
        ret_chunk_out(lds, proj, mix, rowbase, h, lg2, w, r, q);
        ret_state_update(lds, st, w, r, q, g128);
        __syncthreads();
    }
    if (qq == 3) {
#pragma unroll
        for (int t = 0; t < 2; ++t) *(f32x4*)(out + O_RETP + ((size_t)(b * 8 + h) * 64 + 16 * (dt0 + t) + r) * 64 + 16 * et + 4 * q) = st[t];
    }
}

__device__ __forceinline__ void sample_item(lds8* lds, const bf16_t* __restrict__ proj, bf16_t* __restrict__ mix, float* __restrict__ out, const float* __restrict__ state_ret,
                                            const float* __restrict__ cache_k, const float* __restrict__ cache_v, const float* __restrict__ qg, const float* __restrict__ kg, const float* __restrict__ sinks, int b) {
    const int tid = threadIdx.x, lane = tid & 63, w = __builtin_amdgcn_readfirstlane(tid >> 6);
    LAS float* Kf = (LAS float*)(lds);
    LAS float* Vf = (LAS float*)(lds + 35360);
    LAS float* Qf = (LAS float*)(lds + 70176);
    LAS float* Pf = (LAS float*)(lds + 78368);
    const size_t Rs = (size_t)MP + b * 8;
    for (int kvh = 0; kvh < 2; ++kvh) {
        __syncthreads();
        for (int idx = tid; idx < 2048; idx += 512) {
            const int j = idx >> 4, c4 = idx & 15;
            const size_t src = ((size_t)(b * 128 + j) * 2 + kvh) * 64 + c4 * 4;
            const f32x4 kv = *(const f32x4*)(cache_k + src), vv = *(const f32x4*)(cache_v + src);
            LAS float* kd = Kf + j * 65 + c4 * 4; kd[0] = kv[0]; kd[1] = kv[1]; kd[2] = kv[2]; kd[3] = kv[3];
            *(LAS f32x4*)(Vf + j * 64 + c4 * 4) = vv;
            if (j >= 8) { const size_t dst = ((size_t)(b * 128 + j - 8) * 2 + kvh) * 64 + c4 * 4; *(f32x4*)(out + O_KS + dst) = kv; *(f32x4*)(out + O_VS + dst) = vv; }
        }
        if (tid < 64) {
            const int i = tid >> 3, seg = tid & 7;
            const bf16_t* p = proj + (Rs + i) * INW + C_KS + kvh * 64 + seg * 8;
            float kf[8], vf[8]; unpack8(*(const u32x4*)p, kf); unpack8(*(const u32x4*)(p + 128), vf);
            float ss = 0.f;
#pragma unroll
            for (int e = 0; e < 8; ++e) ss += kf[e] * kf[e];
            ss += __shfl_xor(ss, 1); ss += __shfl_xor(ss, 2); ss += __shfl_xor(ss, 4);
            const float rstd = 1.0f / sqrtf(ss * (1.f / 64.f) + EPS);
            const size_t dst = ((size_t)(b * 128 + 120 + i) * 2 + kvh) * 64 + seg * 8;
#pragma unroll
            for (int e = 0; e < 8; ++e) { kf[e] *= rstd * kg[seg * 8 + e]; Kf[(128 + i) * 65 + seg * 8 + e] = kf[e]; Vf[(128 + i) * 64 + seg * 8 + e] = vf[e]; out[O_KS + dst + e] = kf[e]; out[O_VS + dst + e] = vf[e]; }
        } else if (tid < 320) {
            const int idx = tid - 64, rowq = idx >> 3, seg = idx & 7, g = rowq >> 3, i = rowq & 7;
            const bf16_t* p = proj + (Rs + i) * INW + C_QS + (kvh * 4 + g) * 64 + seg * 8;
            float qf[8]; unpack8(*(const u32x4*)p, qf);
            float ss = 0.f;
#pragma unroll
            for (int e = 0; e < 8; ++e) ss += qf[e] * qf[e];
            ss += __shfl_xor(ss, 1); ss += __shfl_xor(ss, 2); ss += __shfl_xor(ss, 4);
            const float rstd = 0.125f / sqrtf(ss * (1.f / 64.f) + EPS);
#pragma unroll
            for (int e = 0; e < 8; ++e) Qf[rowq * 64 + seg * 8 + e] = qf[e] * rstd * qg[seg * 8 + e];
        }
        __syncthreads();
        for (int rr = 0; rr < 4; ++rr) {
            const int rowq = 4 * w + rr, g = rowq >> 3, i = rowq & 7, head = kvh * 4 + g;
            const float slope = exp2f(-(float)(head + 1)), sink = sinks[head];
            float s[3];
#pragma unroll
            for (int t = 0; t < 3; ++t) {
                const int j = lane + 64 * t; float v = -1e30f;
                if (j < 136) {
                    float dot = 0.f;
#pragma unroll 16
                    for (int d = 0; d < 64; ++d) dot += Qf[rowq * 64 + d] * Kf[j * 65 + d];
                    const int dist = 128 + i - j;
                    if (dist >= 0 && dist < 128) v = dot - slope * (float)dist;
                }
                s[t] = v;
            }
            float mx = wave_max(fmaxf(fmaxf(s[0], s[1]), s[2])); mx = fmaxf(mx, sink);
            float p[3], sum = 0.f;
#pragma unroll
            for (int t = 0; t < 3; ++t) { p[t] = __expf(s[t] - mx); sum += p[t]; }
            sum = wave_sum(sum);
            const float inv = 1.0f / (sum + __expf(sink - mx));
#pragma unroll
            for (int t = 0; t < 3; ++t) { const int j = lane + 64 * t; if (j < 136) Pf[w * 136 + j] = p[t] * inv; }
            float o = 0.f;
#pragma unroll 8
            for (int j = 0; j < 136; ++j) o += Pf[w * 136 + j] * Vf[j * 64 + lane];
            mix[(Rs + i) * 1024 + 512 + head * 64 + lane] = (bf16_t)(pkbf(o, 0.f) & 0xffffu);
        }
    }
    __syncthreads();
    {
        const int h = w;
        LAS float* qf = (LAS float*)(lds + w * 4608); LAS float* kf = qf + 512; LAS float* scl = kf + 512;
        const float lg2 = ret_lg2(h);
        float v[8], gg[8];
#pragma unroll
        for (int l = 0; l < 8; ++l) {
            const bf16_t* p = proj + (Rs + l) * INW + h * 64 + lane;
            qf[l * 64 + lane] = bf2f(p[C_QR]); kf[l * 64 + lane] = 0.125f * bf2f(p[C_KR]); v[l] = bf2f(p[C_VR]); gg[l] = bf2f(p[C_GR]);
        }
        float S[64];
        const float* sp = state_ret + ((size_t)(b * 8 + h) * 64) * 64 + lane;
#pragma unroll
        for (int d = 0; d < 64; ++d) S[d] = sp[d * 64];
        {
            const int l = lane >> 3, m = lane & 7; float dot = 0.f;
#pragma unroll 16
            for (int d = 0; d < 64; ++d) dot += qf[l * 64 + d] * kf[m * 64 + d];
            scl[lane] = (m <= l) ? dot * exp2f(lg2 * (float)(l - m)) : 0.f;
        }
#pragma unroll
        for (int l = 0; l < 8; ++l) {
            float cross = 0.f, intra = 0.f;
#pragma unroll
            for (int d = 0; d < 64; ++d) cross += qf[l * 64 + d] * S[d];
#pragma unroll
            for (int m = 0; m < 8; ++m) intra += scl[l * 8 + m] * v[m];
            const float o = intra + exp2f(lg2 * (float)(l + 1)) * cross;
            const float ss = wave_sum(o * o);
            const float rstd = 1.0f / sqrtf(ss * (1.f / 64.f) + EPS);
            const float gl = gg[l], sil = gl / (1.f + __expf(-gl));
            mix[(Rs + l) * 1024 + h * 64 + lane] = (bf16_t)(pkbf(o * rstd * sil, 0.f) & 0xffffu);
        }
        const float g8 = exp2f(lg2 * 8.f);
        float vk[8];
#pragma unroll
        for (int m = 0; m < 8; ++m) vk[m] = v[m] * exp2f(lg2 * (float)(7 - m));
        float* op = out + O_RETS + ((size_t)(b * 8 + h) * 64) * 64 + lane;
#pragma unroll
        for (int d = 0; d < 64; ++d) {
            float acc = S[d] * g8;
#pragma unroll
            for (int m = 0; m < 8; ++m) acc += kf[m * 64 + d] * vk[m];
            op[d * 64] = acc;
        }
    }
    __syncthreads();
}

#define XB_TMO      128
#define XB_XCNT(j)  (256  + 64 * (j))
#define XB_XSUB(j)  (1280 + 64 * (j))
#define XB_XGEN(j)  (2304 + 64 * (j))
#define XB_TOP      3328
#define XB_TOPGEN   3392
#define XCD_BAR_WORDS 3456
#define XB_SPIN_CAP (1u << 18)

__device__ __forceinline__ unsigned xb_ld(unsigned* p)              { return __hip_atomic_load(p, __ATOMIC_RELAXED, __HIP_MEMORY_SCOPE_AGENT); }
__device__ __forceinline__ unsigned xb_add(unsigned* p, unsigned v) { return __hip_atomic_fetch_add(p, v, __ATOMIC_RELAXED, __HIP_MEMORY_SCOPE_AGENT); }
__device__ __forceinline__ unsigned xb_xcc_id() { return (unsigned)__builtin_amdgcn_s_getreg((3 << 11) | 20) & 0xFu; }
#define XB_SPIN(cond, bar) do { unsigned _sp = 0; while (cond) { __builtin_amdgcn_s_sleep(1); \
    if ((++_sp & 255u) == 0u) { if (xb_ld(&(bar)[XB_TMO])) break; if (_sp > XB_SPIN_CAP) { atomicAdd(&(bar)[XB_TMO], 1u); break; } } } } while (0)

struct XcdBarrier {
    unsigned* bar; unsigned x;
    volatile LAS unsigned* st;
};

__device__ __forceinline__ XcdBarrier xcd_barrier_post(unsigned* bar, volatile LAS unsigned* st) {
    XcdBarrier b; b.bar = bar; b.x = xb_xcc_id(); b.st = st;
    if (threadIdx.x == 0) (void)xb_add(&bar[XB_XCNT(b.x)], 1u);
    return b;
}
__device__ __forceinline__ void xcd_barrier_complete(unsigned* bar, unsigned x, unsigned& nloc, unsigned& nx) {
    const unsigned G = gridDim.x * gridDim.y * gridDim.z;
    unsigned sum, cnt, mine, sp = 0u;
    for (;;) {
        sum = 0u; cnt = 0u; mine = 0u;
#pragma unroll
        for (unsigned j = 0; j < 16; ++j) { const unsigned c = xb_ld(&bar[XB_XCNT(j)]); sum += c; cnt += (c > 0u) ? 1u : 0u; mine = (j == x) ? c : mine; }
        if (sum == G) break;
        __builtin_amdgcn_s_sleep(1);
        if ((++sp & 255u) == 0u) { if (xb_ld(&bar[XB_TMO])) break; if (sp > XB_SPIN_CAP) { atomicAdd(&bar[XB_TMO], 1u); break; } }
    }
    nloc = mine > 0u ? mine : 1u; nx = cnt > 0u ? cnt : 1u;
}

__device__ __forceinline__ void xcd_barrier(const XcdBarrier& b) {
    asm volatile("s_waitcnt vmcnt(0)" ::: "memory");
    __syncthreads();
    if (threadIdx.x == 0) {
        unsigned* bar = b.bar;
        __builtin_amdgcn_s_waitcnt(0);
        unsigned nloc = b.st[0], nx = b.st[1];
        if (nloc == 0u) { xcd_barrier_complete(bar, b.x, nloc, nx); b.st[0] = nloc; b.st[1] = nx; }
        const unsigned old = xb_add(&bar[XB_XSUB(b.x)], 1u);
        const unsigned gen = old / nloc;
        if (old + 1u == (gen + 1u) * nloc) {
            __builtin_amdgcn_fence(__ATOMIC_RELEASE, "agent");
            asm volatile("s_waitcnt vmcnt(0)" ::: "memory");
            const unsigned og = xb_add(&bar[XB_TOP], 1u);
            const unsigned tg = og / nx;
            if (og + 1u == (tg + 1u) * nx) xb_add(&bar[XB_TOPGEN], 1u);
            else XB_SPIN(xb_ld(&bar[XB_TOPGEN]) == tg, bar);
            __builtin_amdgcn_fence(__ATOMIC_ACQUIRE, "agent");
            xb_add(&bar[XB_XGEN(b.x)], 1u);
            asm volatile("s_waitcnt vmcnt(0)" ::: "memory");
        } else {
            XB_SPIN(xb_ld(&bar[XB_XGEN(b.x)]) == gen, bar);
            __builtin_amdgcn_fence(__ATOMIC_ACQUIRE, "agent");
            asm volatile("s_waitcnt vmcnt(0)" ::: "memory");
        }
    }
    __syncthreads();
}

struct Args { const float* in[14]; float* out; unsigned char* ws; };
#ifndef PHM
#define PHM 0x7f
#endif
constexpr int SWA_HS = 2;
constexpr int NI_SWA = 8 * 16 * 2 * (4 / SWA_HS), NI_U = 8 * 8 * 15, NI_SMP = 128, NI_A = NI_SWA + NI_U + NI_SMP;

typedef const __attribute__((address_space(4))) Args* kargs_t;
__device__ __forceinline__ kargs_t argp() { kargs_t p = (kargs_t)__builtin_amdgcn_kernarg_segment_ptr(); asm volatile("" : "+s"(p)); return p; }

__global__ void __launch_bounds__(512, 2) fwd_kernel(Args a_unused) {
    extern __shared__ __attribute__((aligned(16))) unsigned char lds_raw[];
    lds8* lds = (lds8*)lds_raw;
    cg::grid_group grid = cg::this_grid();
    const int tid = threadIdx.x, lane = tid & 63, wave = __builtin_amdgcn_readfirstlane(tid >> 6);
    const int G = gridDim.x, bid = blockIdx.x;
    volatile LAS unsigned* bst = (volatile LAS unsigned*)(lds + LDS_BYTES - 64);
    if (tid < 2) bst[tid] = 0u;
    { kargs_t ap = argp(); unsigned* bw = (unsigned*)(ap->ws + WS_BAR); if (bid == 0) for (int i = tid; i < XCD_BAR_WORDS; i += 512) bw[i] = 0u; }
    __syncthreads();

    if (PHM & 1) {
        kargs_t ap = argp(); unsigned char* ws = ap->ws;
        LAS float* scr = (LAS float*)(lds + wave * 16384);
        const int gw = bid * 8 + wave, NGW = G * 8;
        constexpr int I_IN = (D / 64) * (INW / 32), I_OUT = (D / 64) * (D / 32), I_UP = (D / 64) * (FF / 32), I_DN = (FF / 64) * (D / 32);
        for (int it = gw; it < I_IN + I_OUT + I_UP + I_DN; it += NGW) {
            int r = it;
            if (r < I_IN) { transpose_item(ap->in[6], D, INW, (bf16_t*)(ws + WS_WIN), nullptr, scr, r, lane); continue; } r -= I_IN;
            if (r < I_OUT) { transpose_item(ap->in[10], D, D, (bf16_t*)(ws + WS_WOUT), nullptr, scr, r, lane); continue; } r -= I_OUT;
            if (r < I_UP) { transpose_item(ap->in[12], D, FF, (bf16_t*)(ws + WS_WUP), ap->in[11], scr, r, lane); continue; } r -= I_UP;
            transpose_item(ap->in[13], FF, D, (bf16_t*)(ws + WS_WDN), nullptr, scr, r, lane);
        }
        const float* x_prompt = ap->in[0]; const float* x_sample = ap->in[1]; const float* g_mix = ap->in[5];
        bf16_t* XN = (bf16_t*)(ws + WS_XN);
        for (int m = gw; m < M; m += NGW) {
            const float* xr = (m < MP) ? x_prompt + (size_t)m * D : x_sample + (size_t)(m - MP) * D;
            rms_row_to_bf16(xr, g_mix, XN + (size_t)m * D, lane);
        }
        float* rowss = (float*)(ws + WS_CTL);
        for (int i = bid * 512 + tid; i < M; i += G * 512) rowss[i] = 0.f;
    }
    grid.sync();
    XcdBarrier bar; { kargs_t ap = argp(); bar = xcd_barrier_post((unsigned*)(ap->ws + WS_BAR), bst); }
#define GSYNC() xcd_barrier(bar)

    if (PHM & 2) {
        kargs_t ap = argp(); unsigned char* ws = ap->ws;
        pg8::Gemm g{(const bf16_t*)(ws + WS_XN), (const bf16_t*)(ws + WS_WIN), M, INW, D}; pg8::StaticOrder S; S.init(M, INW, G, bid);
        pg8::EpiBf16<0> E{(bf16_t*)(ws + WS_PROJ), INW, nullptr};
        pg8::gemm_phase<pg8::EpiBf16<0>, pg8::StaticOrder, true, true>(lds, g, S, E);
    }
    GSYNC();

#ifdef DUPA
    for (int rep = 0; rep < 2; ++rep) { if (rep) GSYNC();
#endif
    if (PHM & 4) for (int it = bid; it < NI_A; it += G) {
        kargs_t ap = argp(); unsigned char* ws = ap->ws;
        const bf16_t* PROJ = (const bf16_t*)(ws + WS_PROJ);
        if (it < NI_SWA) {
            constexpr int HP = 4 / SWA_HS;
            const int hp = it % HP, kvh = (it / HP) & 1, n = (it / (2 * HP)) & 15, b = it / (32 * HP);
            swa_prompt_item(lds, PROJ, (bf16_t*)(ws + WS_MIX), ap->out, ap->in[7], ap->in[8], ap->in[9], b, n, kvh, hp * SWA_HS, SWA_HS);
        } else if (it < NI_SWA + NI_U) {
            const int r = it - NI_SWA, c = r % 15, h = (r / 15) & 7, b = r / 120;
            ret_u_item(lds, PROJ, (float*)(ws + WS_UST), b, h, c);
        } else {
            sample_item(lds, PROJ, (bf16_t*)(ws + WS_MIX), ap->out, ap->in[2], ap->in[3], ap->in[4], ap->in[7], ap->in[8], ap->in[9], it - NI_SWA - NI_U);
        }
    }
#ifdef DUPA
    }
#endif
    GSYNC();

#ifdef DUPB
    for (int rep = 0; rep < 2; ++rep) { if (rep) GSYNC();
#endif
    if (PHM & 8) for (int it = bid; it < 256; it += G) {
        kargs_t ap = argp(); unsigned char* ws = ap->ws;
        ret_item(lds, (const bf16_t*)(ws + WS_PROJ), (bf16_t*)(ws + WS_MIX), (const float*)(ws + WS_UST), ap->out, it >> 5, (it >> 2) & 7, it & 3);
    }
#ifdef DUPB
    }
#endif
#ifdef XSYNC
    for (int rep = 0; rep < XSYNC; ++rep) GSYNC();
#endif
    GSYNC();

    if (PHM & 16) {
        kargs_t ap = argp(); unsigned char* ws = ap->ws;
        pg8::Gemm g{(const bf16_t*)(ws + WS_MIX), (const bf16_t*)(ws + WS_WOUT), M, D, D}; pg8::StaticOrder S; S.init(M, D, G, bid);
        pg8::EpiRes E{ap->in[0], ap->in[1], ap->out, (bf16_t*)(ws + WS_XN), (float*)(ws + WS_CTL)};
        pg8::gemm_phase<pg8::EpiRes, pg8::StaticOrder, true, true>(lds, g, S, E);
    }
    GSYNC();

    if (PHM & 32) {
        kargs_t ap = argp(); unsigned char* ws = ap->ws;
        pg8::Gemm g{(const bf16_t*)(ws + WS_XN), (const bf16_t*)(ws + WS_WUP), M, FF, D}; pg8::StaticOrder S; S.init(M, FF, G, bid);
        pg8::EpiBf16<1> E{(bf16_t*)(ws + WS_U), FF, (const float*)(ws + WS_CTL)};
        pg8::gemm_phase<pg8::EpiBf16<1>, pg8::StaticOrder, true, true>(lds, g, S, E);
    }
    GSYNC();

    if (PHM & 64) {
        kargs_t ap = argp(); unsigned char* ws = ap->ws;
        pg8::Gemm g{(const bf16_t*)(ws + WS_U), (const bf16_t*)(ws + WS_WDN), M, D, FF}; pg8::StaticOrder S; S.init(M, D, G, bid);
        pg8::EpiDown E{ap->out};
        pg8::gemm_phase<pg8::EpiDown, pg8::StaticOrder, true, true>(lds, g, S, E);
    }
}

extern "C" void kernel_launch(void* const* d_in, const int* in_sizes, int n_in, void* d_out, int out_size, void* d_ws, size_t ws_size, hipStream_t stream) {
    static int grid = 0;
    if (grid == 0) {
        int dev = 0, cus = 0, per_cu = 0;
        (void)hipGetDevice(&dev);
        (void)hipDeviceGetAttribute(&cus, hipDeviceAttributeMultiprocessorCount, dev);
        if (hipFuncSetAttribute((const void*)fwd_kernel, hipFuncAttributeMaxDynamicSharedMemorySize, LDS_BYTES) != hipSuccess) fprintf(stderr, "kernel_launch: hipFuncSetAttribute failed\n");
        if (hipOccupancyMaxActiveBlocksPerMultiprocessor(&per_cu, (const void*)fwd_kernel, 512, LDS_BYTES) != hipSuccess || per_cu < 1) per_cu = 1;
        (void)hipGetLastError();
        if (cus <= 0) cus = 256;
        grid = cus * per_cu;
    }
    Args a{};
    for (int i = 0; i < 14; ++i) a.in[i] = (const float*)d_in[i];
    a.out = (float*)d_out; a.ws = (unsigned char*)d_ws;
    void* params[] = {&a};
    hipError_t e = hipLaunchCooperativeKernel((const void*)fwd_kernel, dim3(grid), dim3(512), params, LDS_BYTES, stream);
    if (e != hipSuccess) fprintf(stderr, "kernel_launch: cooperative launch failed: %s (grid %d)\n", hipGetErrorString(e), grid);
}
```

```cpp
#include <hip/hip_runtime.h>
#include <hip/hip_cooperative_groups.h>
#include <cstdio>
#include <cstdint>
namespace cg = cooperative_groups;
namespace pg8 {
#define PG8_LAS __attribute__((address_space(3)))
typedef unsigned short bf16_t;
typedef short bf16x8 __attribute__((ext_vector_type(8)));
typedef float f32x4 __attribute__((ext_vector_type(4)));
typedef unsigned u32x4 __attribute__((ext_vector_type(4)));
constexpr int BM = 256, BK = 64, HALF = 128, HTB = HALF * BK * 2  , STAGE_BYTES = 8 * HTB, NXCD = 8, WGM = 8;

__host__ __device__ __forceinline__ int lds_byte(int r, int c) { const int st = (r >> 4) * 2 + (c >> 5), rr = r & 15, cc = c & 31, ob = rr * 64 + cc * 2; return st * 1024 + (ob ^ (((ob >> 9) & 1) << 5)); }
__host__ __device__ __forceinline__ void stage_rc(int b, int& R, int& C) { const int st = b / 1024, sb = b % 1024, swz = sb ^ (((sb >> 9) & 1) << 5); R = (st >> 1) * 16 + swz / 64; C = (st & 1) * 32 + (swz % 64) / 2; }
__host__ __device__ __forceinline__ int perm32(int rho) { const int n = rho >> 4, i = rho & 15; return 8 * (i >> 2) + 4 * n + (i & 3); }

struct Unit { int pm, pn, k0, nt; };
struct Gemm { const bf16_t* A; const bf16_t* Bt; int M, N, K; };

struct StaticOrder {
    int nM, nN, nwg, G, c, ntk;
    __host__ __device__ void init(int M, int N, int K, int G_, int c_) { nM = M / BM; nN = N / BM; nwg = nM * nN; G = G_; c = c_; ntk = K / BK; }
    __host__ __device__ bool next(int i, Unit& u) const { return at((long)i * G + c, u); }
    __host__ __device__ bool at(long L, Unit& u) const {
        if (L < 0 || L >= nwg) return false;
        int wgid = (int)L; { const int q = nwg / NXCD, r = nwg % NXCD, xcd = wgid % NXCD, off = wgid / NXCD; wgid = (xcd < r ? xcd * (q + 1) : r * (q + 1) + (xcd - r) * q) + off; }
        const int nig = WGM * nN, gid = wgid / nig, fm = gid * WGM, gsz = (nM - fm) < WGM ? (nM - fm) : WGM;
        u.pm = fm + ((wgid % nig) % gsz); u.pn = (wgid % nig) / gsz; u.k0 = 0; u.nt = ntk; return true;
    }
    __device__ __forceinline__ void a_ready(const Unit&) const {}
    __device__ __forceinline__ void done(const Unit&) const {}
};

__device__ __forceinline__ unsigned cvt_pk_bf16(float lo, float hi) { unsigned r; asm volatile("v_cvt_pk_bf16_f32 %0, %1, %2" : "=v"(r) : "v"(lo), "v"(hi)); return r; }
typedef float f32x2 __attribute__((ext_vector_type(2)));
typedef unsigned u32x2 __attribute__((ext_vector_type(2)));
constexpr int MROWS_PROMPT = 16384;
constexpr float RMS_EPS = 1e-6f;

template <int MODE> struct EpiBf16 {
    static constexpr bool PERM = true, AFTER_DRAIN = false;
    bf16_t* O; int ldc; const float* rowss;
    __device__ __forceinline__ void operator()(const f32x4 (&acc)[2][2][4][2], const Unit& u, int wr, int wc, int fr, int fq) const {
        const int row0 = u.pm * BM + wr * 64 + fr, col0 = u.pn * BM + wc * 32 + 8 * fq;
#pragma unroll
        for (int ai = 0; ai < 2; ++ai)
#pragma unroll
            for (int m = 0; m < 4; ++m) {
                const int row = row0 + ai * HALF + m * 16;
                float sc = 1.f;
                if (MODE == 1) sc = __builtin_amdgcn_rsqf(rowss[row] * (1.0f / 1024.0f) + RMS_EPS);
                bf16_t* rowp = O + (size_t)row * ldc + col0;
#pragma unroll
                for (int bj = 0; bj < 2; ++bj) {
                    f32x4 v0 = acc[ai][bj][m][0], v1 = acc[ai][bj][m][1];
                    if (MODE == 1) {
                        v0 = v0 * sc; v1 = v1 * sc;
#pragma unroll
                        for (int e = 0; e < 4; ++e) { const float a = fmaxf(v0[e], 0.f), b = fmaxf(v1[e], 0.f); v0[e] = a * a; v1[e] = b * b; }
                    }
                    u32x4 w; w.x = cvt_pk_bf16(v0[0], v0[1]); w.y = cvt_pk_bf16(v0[2], v0[3]); w.z = cvt_pk_bf16(v1[0], v1[1]); w.w = cvt_pk_bf16(v1[2], v1[3]);
                    *(u32x4*)(rowp + bj * HALF) = w;
                }
            }
    }
};

struct EpiRes {
    static constexpr bool PERM = false, AFTER_DRAIN = false;
    const float* xp; const float* xs; float* out; bf16_t* hb; float* rowss;
    __device__ __forceinline__ void operator()(const f32x4 (&acc)[2][2][4][2], const Unit& u, int wr, int wc, int fr, int fq) const {
        const int row0 = u.pm * BM + wr * 64 + fr, col0 = u.pn * BM + wc * 32 + 4 * fq;
#pragma unroll
        for (int ai = 0; ai < 2; ++ai)
#pragma unroll
            for (int m = 0; m < 4; ++m) {
                const int row = row0 + ai * HALF + m * 16;
                const float* xrow = (row < MROWS_PROMPT) ? xp + (size_t)row * 1024 : xs + (size_t)(row - MROWS_PROMPT) * 1024;
                float ss = 0.f;
#pragma unroll
                for (int bj = 0; bj < 2; ++bj)
#pragma unroll
                    for (int n = 0; n < 2; ++n) {
                        const int col = col0 + bj * HALF + n * 16;
                        const f32x4 h = *(const f32x4*)(xrow + col) + acc[ai][bj][m][n];
                        *(f32x4*)(out + (size_t)row * 1024 + col) = h;
                        ss += (h[0] * h[0] + h[1] * h[1]) + (h[2] * h[2] + h[3] * h[3]);
                        u32x2 w; w.x = cvt_pk_bf16(h[0], h[1]); w.y = cvt_pk_bf16(h[2], h[3]);
                        *(u32x2*)(hb + (size_t)row * 1024 + col) = w;
                    }
                ss += __shfl_xor(ss, 16); ss += __shfl_xor(ss, 32);
                if (fq == 0) __hip_atomic_fetch_add(rowss + row, ss, __ATOMIC_RELAXED, __HIP_MEMORY_SCOPE_AGENT);
            }
    }
};

constexpr int DN_SLICES = 8, DN_UNITS = 16 * DN_SLICES;
struct DownOrder {
    StaticOrder so; int G, c;
    __host__ __device__ void init(int K, int G_, int c_) { so.init(MROWS_PROMPT, 1024, K, G_, c_); G = G_; c = c_; }
    __host__ __device__ bool next(int i, Unit& u) const {
        const long L = (long)i * G + c;
        if (L >= DN_UNITS) return so.at(L - DN_UNITS, u);
        const int tile = (int)L / DN_SLICES, slice = (int)L % DN_SLICES;
        u.pm = 64 + (tile >> 2); u.pn = tile & 3; u.k0 = slice * (4096 / DN_SLICES); u.nt = 64 / DN_SLICES; return true;
    }
    __device__ __forceinline__ void a_ready(const Unit&) const {}
    __device__ __forceinline__ void done(const Unit&) const {}
};
struct EpiDown {
    static constexpr bool PERM = false, AFTER_DRAIN = false;
    float* out; float* part;
    __device__ __forceinline__ void operator()(const f32x4 (&acc)[2][2][4][2], const Unit& u, int wr, int wc, int fr, int fq) const {
        const int row0 = u.pm * BM + wr * 64 + fr, col0 = u.pn * BM + wc * 32 + 4 * fq;
        const bool sl = u.pm >= 64;
        float* base = sl ? part + ((size_t)(u.k0 / (4096 / DN_SLICES)) * 1024 - MROWS_PROMPT) * 1024 : out;
#pragma unroll
        for (int ai = 0; ai < 2; ++ai)
#pragma unroll
            for (int m = 0; m < 4; ++m) {
                float* orow = base + (size_t)(row0 + ai * HALF + m * 16) * 1024 + col0;
#pragma unroll
                for (int bj = 0; bj < 2; ++bj)
#pragma unroll
                    for (int n = 0; n < 2; ++n) { float* p = orow + bj * HALF + n * 16; const f32x4 v = acc[ai][bj][m][n];
                        if (sl) *(f32x4*)p = v; else *(f32x4*)p = *(const f32x4*)p + v; }
            }
    }
};
template <class Epi, class Sched, bool ALIGN_EPI = false, bool SP2 = false>
__device__ __forceinline__ void gemm_phase(PG8_LAS unsigned char* lds, const Gemm g, const Sched& S, const Epi& E) {
    const int tid = threadIdx.x, wid = __builtin_amdgcn_readfirstlane(tid >> 6), lane = tid & 63, wr = wid >> 2, wc = wid & 3, fr = lane & 15, fq = lane >> 4;
    const int K = g.K;
    unsigned voffA[2], voffB[2];
#pragma unroll
    for (int i = 0; i < 2; ++i) { int R, C; stage_rc(tid * 16 + i * 8192, R, C); const int Rb = Epi::PERM ? ((R & ~31) + perm32(R & 31)) : R;
        voffA[i] = (unsigned)(R * K + C) * 2u; voffB[i] = (unsigned)(Rb * K + C) * 2u; }
    const size_t kstep = (size_t)(BK * 2);
    const size_t hstep = (size_t)HALF * K * 2;
    const size_t tstep = 2 * hstep;
    const unsigned ldsw = (unsigned)wid * 1024u;
    const int aoff = lds_byte(wr * 64 + fr, fq * 8), boff = lds_byte(wc * 32 + fr, fq * 8);
#define PG8_SA(b, h) (((b) * 2 + (h)) * HTB)
#define PG8_SB(b, h) ((4 + (b) * 2 + (h)) * HTB)
#define PG8_STAGE(bufoff, gbase, voff) do { _Pragma("unroll") for (int _i = 0; _i < 2; ++_i) \
        __builtin_amdgcn_global_load_lds((const unsigned*)((const char*)(gbase) + (voff)[_i]), (PG8_LAS unsigned*)(lds + (bufoff) + ldsw + _i * 8192), 16, 0, 0); } while (0)
#define PG8_LDA(dst, b, h) do { _Pragma("unroll") for (int m = 0; m < 4; ++m) _Pragma("unroll") for (int k = 0; k < 2; ++k) dst[m][k] = *(const PG8_LAS bf16x8*)(lds + PG8_SA(b, h) + aoff + m * 2048 + k * 1024); } while (0)
#define PG8_LDB(dst, b, h) do { _Pragma("unroll") for (int n = 0; n < 2; ++n) _Pragma("unroll") for (int k = 0; k < 2; ++k) dst[n][k] = *(const PG8_LAS bf16x8*)(lds + PG8_SB(b, h) + boff + n * 2048 + k * 1024); } while (0)
#define PG8_MMA(ai, bj, At, Bt) do { __builtin_amdgcn_s_setprio(1); _Pragma("unroll") for (int m = 0; m < 4; ++m) _Pragma("unroll") for (int n = 0; n < 2; ++n) _Pragma("unroll") for (int k = 0; k < 2; ++k) \
        acc[ai][bj][m][n] = __builtin_amdgcn_mfma_f32_16x16x32_bf16(Bt[n][k], At[m][k], acc[ai][bj][m][n], 0, 0, 0); __builtin_amdgcn_s_setprio(0); } while (0)
#define PG8_WAIT_V(n) asm volatile("s_waitcnt vmcnt(" #n ")" ::: "memory")
#define PG8_WAIT_L(n) asm volatile("s_waitcnt lgkmcnt(" #n ")" ::: "memory")
#define PG8_BAR __builtin_amdgcn_s_barrier()
#define PG8_SCHED __builtin_amdgcn_sched_barrier(0)
    Unit cur, nxt; int ui = 0;
    if (!S.next(0, cur)) return;
    f32x4 acc[2][2][4][2];
#pragma unroll
    for (int a = 0; a < 2; ++a)
#pragma unroll
        for (int b = 0; b < 2; ++b)
#pragma unroll
            for (int m = 0; m < 4; ++m)
#pragma unroll
                for (int n = 0; n < 2; ++n) acc[a][b][m][n] = (f32x4){0.f, 0.f, 0.f, 0.f};
    bf16x8 At[4][2], B0[2][2], B1[2][2];
    const char* cA = (const char*)g.A + (size_t)cur.pm * tstep + (size_t)cur.k0 * 2; const char* cB = (const char*)g.Bt + (size_t)cur.pn * tstep + (size_t)cur.k0 * 2;
    S.a_ready(cur);
    if constexpr (SP2) {
        PG8_STAGE(PG8_SB(0, 0), cB, voffB); PG8_STAGE(PG8_SB(0, 1), cB + hstep, voffB); PG8_STAGE(PG8_SA(0, 0), cA, voffA); PG8_STAGE(PG8_SA(0, 1), cA + hstep, voffA);
        if (wr == 1) PG8_BAR;
        PG8_WAIT_V(2); PG8_BAR;
        PG8_STAGE(PG8_SB(1, 0), cB + kstep, voffB); PG8_STAGE(PG8_SA(1, 0), cA + kstep, voffA); PG8_STAGE(PG8_SB(1, 1), cB + hstep + kstep, voffB);
        PG8_WAIT_V(6); PG8_BAR;
    } else {
        PG8_STAGE(PG8_SB(0, 0), cB, voffB); PG8_STAGE(PG8_SA(0, 0), cA, voffA); PG8_STAGE(PG8_SB(0, 1), cB + hstep, voffB); PG8_STAGE(PG8_SA(0, 1), cA + hstep, voffA);
        if (wr == 1) PG8_BAR;
        PG8_WAIT_V(4); PG8_BAR;
        PG8_STAGE(PG8_SB(1, 0), cB + kstep, voffB); PG8_STAGE(PG8_SA(1, 0), cA + kstep, voffA); PG8_STAGE(PG8_SB(1, 1), cB + hstep + kstep, voffB);
        PG8_WAIT_V(6); PG8_BAR;
    }
    for (;;) {
        const bool has_next = S.next(ui + 1, nxt);
        const char* nA = has_next ? (const char*)g.A + (size_t)nxt.pm * tstep + (size_t)nxt.k0 * 2 : cA; const char* nB = has_next ? (const char*)g.Bt + (size_t)nxt.pn * tstep + (size_t)nxt.k0 * 2 : cB;
        const int nt = cur.nt;
        for (int t = 0; t < nt; t += 2) {
            const bool last = (t == nt - 2);
            const char* a1 = cA + (size_t)(t + 1) * kstep;
            const char* a2 = last ? nA : cA + (size_t)(t + 2) * kstep; const char* b2 = last ? nB : cB + (size_t)(t + 2) * kstep;
            const char* a3 = a2 + kstep; const char* b3 = b2 + kstep;
            if (last && has_next) S.a_ready(nxt);
            if constexpr (SP2) {
            PG8_LDB(B0, 0, 0); PG8_LDB(B1, 0, 1); PG8_SCHED; PG8_LDA(At, 0, 0); PG8_STAGE(PG8_SA(1, 1), a1 + hstep, voffA);
            PG8_WAIT_V(8); PG8_WAIT_L(0); PG8_BAR; PG8_MMA(0, 0, At, B0); PG8_MMA(0, 1, At, B1); PG8_BAR; PG8_SCHED;
            PG8_LDA(At, 0, 1); PG8_STAGE(PG8_SB(0, 0), b2, voffB); PG8_STAGE(PG8_SB(0, 1), b2 + hstep, voffB); PG8_STAGE(PG8_SA(0, 0), a2, voffA);
            PG8_WAIT_V(8); PG8_WAIT_L(0); PG8_BAR; PG8_MMA(1, 0, At, B0); PG8_MMA(1, 1, At, B1); PG8_BAR; PG8_SCHED;
            PG8_LDB(B0, 1, 0); PG8_LDB(B1, 1, 1); PG8_SCHED; PG8_LDA(At, 1, 0); PG8_STAGE(PG8_SA(0, 1), a2 + hstep, voffA);
            PG8_WAIT_V(8); PG8_WAIT_L(0); PG8_BAR; PG8_MMA(0, 0, At, B0); PG8_MMA(0, 1, At, B1); PG8_BAR; PG8_SCHED;
            PG8_LDA(At, 1, 1); PG8_STAGE(PG8_SB(1, 0), b3, voffB); PG8_STAGE(PG8_SB(1, 1), b3 + hstep, voffB); PG8_STAGE(PG8_SA(1, 0), a3, voffA);
            PG8_WAIT_V(8); PG8_WAIT_L(0); PG8_BAR; PG8_MMA(1, 0, At, B0); PG8_MMA(1, 1, At, B1); PG8_BAR; PG8_SCHED;
            } else {
            PG8_LDB(B0, 0, 0); PG8_SCHED; PG8_LDA(At, 0, 0); PG8_STAGE(PG8_SA(1, 1), a1 + hstep, voffA);
            PG8_WAIT_L(8); PG8_BAR; PG8_WAIT_L(0); PG8_MMA(0, 0, At, B0); PG8_BAR; PG8_SCHED;
            PG8_LDB(B1, 0, 1); PG8_STAGE(PG8_SB(0, 0), b2, voffB);
            PG8_BAR; PG8_WAIT_L(0); PG8_MMA(0, 1, At, B1); PG8_BAR;
            PG8_LDA(At, 0, 1); PG8_STAGE(PG8_SA(0, 0), a2, voffA);
            PG8_BAR; PG8_WAIT_L(0); PG8_MMA(1, 0, At, B0); PG8_BAR; PG8_SCHED;
            PG8_STAGE(PG8_SB(0, 1), b2 + hstep, voffB);
            PG8_WAIT_V(6); PG8_BAR; PG8_MMA(1, 1, At, B1); PG8_BAR;
            PG8_LDB(B0, 1, 0); PG8_SCHED; PG8_LDA(At, 1, 0); PG8_STAGE(PG8_SA(0, 1), a2 + hstep, voffA);
            PG8_WAIT_L(8); PG8_BAR; PG8_WAIT_L(0); PG8_MMA(0, 0, At, B0); PG8_BAR; PG8_SCHED;
            PG8_LDB(B1, 1, 1); PG8_STAGE(PG8_SB(1, 0), b3, voffB);
            PG8_BAR; PG8_WAIT_L(0); PG8_MMA(0, 1, At, B1); PG8_BAR;
            PG8_LDA(At, 1, 1); PG8_STAGE(PG8_SA(1, 0), a3, voffA);
            PG8_BAR; PG8_WAIT_L(0); PG8_MMA(1, 0, At, B0); PG8_BAR; PG8_SCHED;
            PG8_STAGE(PG8_SB(1, 1), b3 + hstep, voffB);
            PG8_WAIT_V(6); PG8_BAR; PG8_MMA(1, 1, At, B1); PG8_BAR;
            }
        }
        if constexpr (ALIGN_EPI) { if (wr == 0) PG8_BAR; }
        if constexpr (!Epi::AFTER_DRAIN) { E(acc, cur, wr, wc, fr, fq); S.done(cur); }
        if (!has_next) break;
#pragma unroll
        for (int a = 0; a < 2; ++a)
#pragma unroll
            for (int b = 0; b < 2; ++b)
#pragma unroll
                for (int m = 0; m < 4; ++m)
#pragma unroll
                    for (int n = 0; n < 2; ++n) acc[a][b][m][n] = (f32x4){0.f, 0.f, 0.f, 0.f};
        cur = nxt; cA = nA; cB = nB; ++ui;
        if constexpr (ALIGN_EPI) { if (wr == 1) PG8_BAR; }
    }
    PG8_WAIT_V(0);
    if constexpr (!ALIGN_EPI) { if (wr == 0) PG8_BAR; }
    PG8_BAR;
    if constexpr (Epi::AFTER_DRAIN) { E.fused(acc, cur, wr, wc, fr, fq, lds, wid, lane); S.done(cur); }
#undef PG8_SA
#undef PG8_SB
#undef PG8_STAGE
#undef PG8_LDA
#undef PG8_LDB
#undef PG8_MMA
#undef PG8_WAIT_V
#undef PG8_WAIT_L
#undef PG8_BAR
#undef PG8_SCHED
}
}
#define LAS __attribute__((address_space(3)))
typedef unsigned short bf16_t;
typedef short bf16x8 __attribute__((ext_vector_type(8)));
typedef float f32x4 __attribute__((ext_vector_type(4)));
typedef unsigned u32x4 __attribute__((ext_vector_type(4)));
typedef unsigned u32x2 __attribute__((ext_vector_type(2)));
typedef LAS unsigned char lds8;

constexpr int D = 1024, INW = 2816, FF = 4096;
constexpr int MP = 16384, MS = 1024, M = MP + MS;
constexpr int C_QR = 0, C_KR = 512, C_VR = 1024, C_GR = 1536, C_QS = 2048, C_KS = 2560, C_VS = 2688;
constexpr size_t O_RETP = 17825792, O_KP = 18087936, O_VP = 18219008, O_RETS = 18350080, O_KS = 22544384, O_VS = 24641536;
constexpr size_t MiB = 1u << 20;
constexpr size_t WS_CTL = 0, WS_WIN = 1 * MiB, WS_WOUT = 7 * MiB, WS_WUP = 9 * MiB, WS_WDN = 17 * MiB;
constexpr size_t WS_XN = 25 * MiB;
constexpr size_t WS_PROJ = 59 * MiB;
constexpr size_t WS_MIX = 153 * MiB;
constexpr size_t WS_U = 59 * MiB;
constexpr size_t WS_UST = 196 * MiB;
constexpr size_t WS_PART = 212 * MiB;
constexpr size_t WS_BAR = 131072;
constexpr int LDS_BYTES = 147456;
constexpr float EPS = 1e-6f, LOG2E = 1.4426950408889634f;

__device__ __forceinline__ unsigned pkbf(float lo, float hi) { return pg8::cvt_pk_bf16(lo, hi); }
__device__ __forceinline__ float bflo(unsigned u) { return __uint_as_float(u << 16); }
__device__ __forceinline__ float bfhi(unsigned u) { return __uint_as_float(u & 0xffff0000u); }
__device__ __forceinline__ float bf2f(bf16_t h) { return __uint_as_float((unsigned)h << 16); }
__device__ __forceinline__ void unpack8(const u32x4 v, float (&f)[8]) { f[0] = bflo(v.x); f[1] = bfhi(v.x); f[2] = bflo(v.y); f[3] = bfhi(v.y); f[4] = bflo(v.z); f[5] = bfhi(v.z); f[6] = bflo(v.w); f[7] = bfhi(v.w); }
__device__ __forceinline__ u32x4 pack8(const float (&f)[8]) { u32x4 o; o.x = pkbf(f[0], f[1]); o.y = pkbf(f[2], f[3]); o.z = pkbf(f[4], f[5]); o.w = pkbf(f[6], f[7]); return o; }
__device__ __forceinline__ bf16x8 ldsr128(const lds8* p) { return *(const LAS bf16x8*)p; }
__device__ __forceinline__ void ldsw128(lds8* p, u32x4 v) { *(LAS u32x4*)p = v; }
__device__ __forceinline__ void ldsw64(lds8* p, u32x2 v) { *(LAS u32x2*)p = v; }
__device__ __forceinline__ void ldsw16(lds8* p, unsigned v) { *(LAS unsigned short*)p = (unsigned short)v; }
__device__ __forceinline__ f32x4 mfma16(bf16x8 a, bf16x8 b, f32x4 c) { return __builtin_amdgcn_mfma_f32_16x16x32_bf16(a, b, c, 0, 0, 0); }
__device__ __forceinline__ float wave_sum(float v) {
#pragma unroll
    for (int o = 1; o < 64; o <<= 1) v += __shfl_xor(v, o);
    return v;
}
__device__ __forceinline__ float wave_max(float v) {
#pragma unroll
    for (int o = 1; o < 64; o <<= 1) v = fmaxf(v, __shfl_xor(v, o));
    return v;
}
__device__ __forceinline__ float ex2(float x) { return __builtin_amdgcn_exp2f(x); }

__device__ __forceinline__ void transpose_item(const float* __restrict__ W, int K, int N, bf16_t* __restrict__ WT, const float* __restrict__ gain, LAS float* scr, int item, int lane) {
    const int nblk = N / 32, kb = item / nblk, nb = item % nblk, k0 = 64 * kb, n0 = 32 * nb;
#pragma unroll 8
    for (int i = 0; i < 32; ++i) { const int kk = 2 * i + (lane >> 5); const float g = gain ? gain[k0 + kk] : 1.f; scr[kk * 33 + (lane & 31)] = W[(size_t)(k0 + kk) * N + n0 + (lane & 31)] * g; }
    asm volatile("s_waitcnt lgkmcnt(0)" ::: "memory");
    const int c = lane & 7;
#pragma unroll
    for (int j = 0; j < 4; ++j) { const int n = (lane >> 3) + 8 * j; const LAS float* s = scr + (8 * c) * 33 + n;
        u32x4 o; o.x = pkbf(s[0 * 33], s[1 * 33]); o.y = pkbf(s[2 * 33], s[3 * 33]); o.z = pkbf(s[4 * 33], s[5 * 33]); o.w = pkbf(s[6 * 33], s[7 * 33]);
        *(u32x4*)(WT + (size_t)(n0 + n) * K + k0 + 8 * c) = o; }
    asm volatile("s_waitcnt lgkmcnt(0)" ::: "memory");
}
__device__ __forceinline__ void rms_row_to_bf16(const float* __restrict__ xrow, const float* __restrict__ gain, bf16_t* __restrict__ orow, int lane) {
    const f32x4* xr = (const f32x4*)xrow + lane; const f32x4* gr = (const f32x4*)gain + lane;
    f32x4 v[4]; float s = 0.f;
#pragma unroll
    for (int j = 0; j < 4; ++j) { v[j] = xr[64 * j]; s += (v[j].x * v[j].x + v[j].y * v[j].y) + (v[j].z * v[j].z + v[j].w * v[j].w); }
    const float rstd = 1.0f / sqrtf(wave_sum(s) * (1.f / D) + EPS);
    u32x2* o8 = (u32x2*)orow + lane;
#pragma unroll
    for (int j = 0; j < 4; ++j) { const f32x4 g = gr[64 * j]; u32x2 o; o.x = pkbf(v[j].x * rstd * g.x, v[j].y * rstd * g.y); o.y = pkbf(v[j].z * rstd * g.z, v[j].w * rstd * g.w); o8[64 * j] = o; }
}

__device__ __forceinline__ void swa_prompt_item(lds8* lds, const bf16_t* __restrict__ proj, bf16_t* __restrict__ mix, float* __restrict__ out,
                                                const float* __restrict__ qg, const float* __restrict__ kg, const float* __restrict__ sinks, int b, int n, int kvh, int h0, int nh) {
    const int tid = threadIdx.x, lane = tid & 63, w = __builtin_amdgcn_readfirstlane(tid >> 6), r = lane & 15, q = lane >> 4;
    constexpr int KS = 0, KSTR = 144, VT = 36864, VSTR = 528, QS = 70656, QSTR = 144, PS = 89088, PSTR = 336, PWAVE = 5376;
    const size_t rowb = (size_t)b * 2048;
    for (int idx = tid; idx < 2048; idx += 512) {
        const int row = idx >> 3, seg = idx & 7, t = (n - 1) * 128 + row;
        float kf[8]; u32x4 vr = (u32x4){0u, 0u, 0u, 0u};
        if (t >= 0) { const bf16_t* p = proj + (rowb + t) * INW + C_KS + kvh * 64 + seg * 8; const u32x4 kr = *(const u32x4*)p; vr = *(const u32x4*)(p + 128); unpack8(kr, kf); }
        else {
#pragma unroll
            for (int e = 0; e < 8; ++e) kf[e] = 0.f; }
        float ss = 0.f;
#pragma unroll
        for (int e = 0; e < 8; ++e) ss += kf[e] * kf[e];
        ss += __shfl_xor(ss, 1); ss += __shfl_xor(ss, 2); ss += __shfl_xor(ss, 4);
        const float rstd = 1.0f / sqrtf(ss * (1.f / 64.f) + EPS);
#pragma unroll
        for (int e = 0; e < 8; ++e) kf[e] *= rstd * kg[seg * 8 + e];
        ldsw128(lds + KS + row * KSTR + seg * 16, pack8(kf));
        lds8* vt = lds + VT + (seg * 8) * VSTR + row * 2;
        ldsw16(vt + 0 * VSTR, vr.x & 0xffffu); ldsw16(vt + 1 * VSTR, vr.x >> 16); ldsw16(vt + 2 * VSTR, vr.y & 0xffffu); ldsw16(vt + 3 * VSTR, vr.y >> 16);
        ldsw16(vt + 4 * VSTR, vr.z & 0xffffu); ldsw16(vt + 5 * VSTR, vr.z >> 16); ldsw16(vt + 6 * VSTR, vr.w & 0xffffu); ldsw16(vt + 7 * VSTR, vr.w >> 16);
        if (n == 15 && h0 == 0 && row >= 128) {
            const size_t dst = ((size_t)(b * 128 + row - 128) * 2 + kvh) * 64 + seg * 8;
            float vf[8]; unpack8(vr, vf);
            *(f32x4*)(out + O_KP + dst) = (f32x4){kf[0], kf[1], kf[2], kf[3]}; *(f32x4*)(out + O_KP + dst + 4) = (f32x4){kf[4], kf[5], kf[6], kf[7]};
            *(f32x4*)(out + O_VP + dst) = (f32x4){vf[0], vf[1], vf[2], vf[3]}; *(f32x4*)(out + O_VP + dst + 4) = (f32x4){vf[4], vf[5], vf[6], vf[7]};
        }
    }
    for (int hh = h0; hh < h0 + nh; ++hh) {
        const int head = kvh * 4 + hh;
        __syncthreads();
        for (int idx = tid; idx < 1024; idx += 512) {
            const int row = idx >> 3, seg = idx & 7;
            const bf16_t* p = proj + (rowb + n * 128 + row) * INW + C_QS + head * 64 + seg * 8;
            float qf[8]; unpack8(*(const u32x4*)p, qf);
            float ss = 0.f;
#pragma unroll
            for (int e = 0; e < 8; ++e) ss += qf[e] * qf[e];
            ss += __shfl_xor(ss, 1); ss += __shfl_xor(ss, 2); ss += __shfl_xor(ss, 4);
            const float rstd = (0.125f * LOG2E) / sqrtf(ss * (1.f / 64.f) + EPS);
#pragma unroll
            for (int e = 0; e < 8; ++e) qf[e] *= rstd * qg[seg * 8 + e];
            ldsw128(lds + QS + row * QSTR + seg * 16, pack8(qf));
        }
        __syncthreads();
        const float slope2 = exp2f(-(float)(head + 1)) * LOG2E, sink2 = sinks[head] * LOG2E;
        const bf16x8 yq0 = ldsr128(lds + QS + (16 * w + r) * QSTR + 16 * q), yq1 = ldsr128(lds + QS + (16 * w + r) * QSTR + 16 * q + 64);
        f32x4 sc[9];
#pragma unroll
        for (int j = 0; j < 9; ++j) {
            const lds8* kp = lds + KS + (16 * (w + j) + r) * KSTR + 16 * q;
            sc[j] = mfma16(ldsr128(kp), yq0, (f32x4){0.f, 0.f, 0.f, 0.f});
            sc[j] = mfma16(ldsr128(kp + 64), yq1, sc[j]);
        }
        const int qi = 16 * w + r;
        float mx = sink2;
#pragma unroll
        for (int j = 0; j < 9; ++j)
#pragma unroll
            for (int i = 0; i < 4; ++i) {
                const int key = 16 * (w + j) + 4 * q + i, dist = 128 + qi - key;
                const bool valid = (dist >= 0) && (dist < 128) && (n > 0 || key >= 128);
                const float v = valid ? sc[j][i] - slope2 * (float)dist : -1e30f;
                sc[j][i] = v; mx = fmaxf(mx, v);
            }
        mx = fmaxf(mx, __shfl_xor(mx, 16)); mx = fmaxf(mx, __shfl_xor(mx, 32));
        float sum = 0.f;
#pragma unroll
        for (int j = 0; j < 9; ++j)
#pragma unroll
            for (int i = 0; i < 4; ++i) { const float p = ex2(sc[j][i] - mx); sc[j][i] = p; sum += p; }
        sum += __shfl_xor(sum, 16); sum += __shfl_xor(sum, 32);
        const float inv = 1.0f / (sum + ex2(sink2 - mx));
        lds8* pw = lds + PS + w * PWAVE + r * PSTR;
#pragma unroll
        for (int j = 0; j < 9; ++j) { const int slot = j + (w & 1); u32x2 v; v.x = pkbf(sc[j][0] * inv, sc[j][1] * inv); v.y = pkbf(sc[j][2] * inv, sc[j][3] * inv); ldsw64(pw + (slot * 16 + 4 * q) * 2, v); }
        { const int zs = (w & 1) ? 0 : 9; ldsw64(pw + (zs * 16 + 4 * q) * 2, (u32x2){0u, 0u}); }
        f32x4 o[4];
#pragma unroll
        for (int et = 0; et < 4; ++et) o[et] = (f32x4){0.f, 0.f, 0.f, 0.f};
        const int s0 = 16 * (w & ~1);
#pragma unroll
        for (int ks = 0; ks < 5; ++ks) {
            const bf16x8 yp = ldsr128(pw + (32 * ks + 8 * q) * 2);
#pragma unroll
            for (int et = 0; et < 4; ++et) o[et] = mfma16(ldsr128(lds + VT + (16 * et + r) * VSTR + (s0 + 32 * ks + 8 * q) * 2), yp, o[et]);
        }
        bf16_t* op = mix + (rowb + n * 128 + qi) * 1024 + 512 + head * 64 + 4 * q;
#pragma unroll
        for (int et = 0; et < 4; ++et) { u32x2 v; v.x = pkbf(o[et][0], o[et][1]); v.y = pkbf(o[et][2], o[et][3]); *(u32x2*)(op + 16 * et) = v; }
    }
    __syncthreads();
}

constexpr int RQ = 0, RK = 18432, RVT = 36864, RKD = 54272, RP = 71680, RST = 106496, RSTR = 144, TSTR = 272;
__device__ __forceinline__ void ret_stage(lds8* lds, const bf16_t* __restrict__ proj, size_t rowbase, int h, float lg2, bool full) {
    const int tid = threadIdx.x;
    for (int idx = tid; idx < 1024; idx += 512) {
        const int row = idx >> 3, seg = idx & 7;
        const bf16_t* p = proj + (rowbase + row) * INW + h * 64 + seg * 8;
        const u32x4 kr = *(const u32x4*)(p + C_KR), vr = *(const u32x4*)(p + C_VR);
        float kf[8]; unpack8(kr, kf);
        const float kd = exp2f(lg2 * (float)(127 - row)) * 0.125f;
        lds8* kt = lds + RKD + (seg * 8) * TSTR + row * 2;
#pragma unroll
        for (int e = 0; e < 8; e += 2) { const unsigned pk = pkbf(kf[e] * kd, kf[e + 1] * kd); ldsw16(kt + e * TSTR, pk & 0xffffu); ldsw16(kt + (e + 1) * TSTR, pk >> 16); }
        lds8* vt = lds + RVT + (seg * 8) * TSTR + row * 2;
        ldsw16(vt + 0 * TSTR, vr.x & 0xffffu); ldsw16(vt + 1 * TSTR, vr.x >> 16); ldsw16(vt + 2 * TSTR, vr.y & 0xffffu); ldsw16(vt + 3 * TSTR, vr.y >> 16);
        ldsw16(vt + 4 * TSTR, vr.z & 0xffffu); ldsw16(vt + 5 * TSTR, vr.z >> 16); ldsw16(vt + 6 * TSTR, vr.w & 0xffffu); ldsw16(vt + 7 * TSTR, vr.w >> 16);
        if (full) {
#pragma unroll
            for (int e = 0; e < 8; ++e) kf[e] *= 0.125f;
            ldsw128(lds + RK + row * RSTR + seg * 16, pack8(kf));
            ldsw128(lds + RQ + row * RSTR + seg * 16, *(const u32x4*)(p + C_QR));
        }
    }
}
__device__ __forceinline__ void ret_state_update(const lds8* lds, f32x4 (&st)[2], int w, int r, int q, float dec) {
    const int et = w >> 1, dt0 = 2 * (w & 1);
    st[0] = st[0] * dec; st[1] = st[1] * dec;
#pragma unroll
    for (int ks = 0; ks < 4; ++ks) {
        const bf16x8 a = ldsr128(lds + RVT + (16 * et + r) * TSTR + (32 * ks + 8 * q) * 2);
#pragma unroll
        for (int t = 0; t < 2; ++t) st[t] = mfma16(a, ldsr128(lds + RKD + (16 * (dt0 + t) + r) * TSTR + (32 * ks + 8 * q) * 2), st[t]);
    }
}
__device__ __forceinline__ void ret_chunk_out(lds8* lds, const bf16_t* __restrict__ proj, bf16_t* __restrict__ mix, size_t rowbase, int h, float lg2, int w, int r, int q) {
    const int l = 16 * w + r;
    const bf16x8 yq0 = ldsr128(lds + RQ + l * RSTR + 16 * q), yq1 = ldsr128(lds + RQ + l * RSTR + 16 * q + 64);
    lds8* prow = lds + RP + l * TSTR;
    for (int mt = 0; mt <= w; ++mt) {
        const lds8* kp = lds + RK + (16 * mt + r) * RSTR + 16 * q;
        f32x4 d = mfma16(ldsr128(kp), yq0, (f32x4){0.f, 0.f, 0.f, 0.f});
        d = mfma16(ldsr128(kp + 64), yq1, d);
        float pv[4];
#pragma unroll
        for (int i = 0; i < 4; ++i) { const int dl = l - (16 * mt + 4 * q + i); pv[i] = (dl >= 0) ? d[i] * exp2f(lg2 * (float)dl) : 0.f; }
        u32x2 v; v.x = pkbf(pv[0], pv[1]); v.y = pkbf(pv[2], pv[3]);
        ldsw64(prow + (16 * mt + 4 * q) * 2, v);
    }
    if ((w & 1) == 0) ldsw64(prow + (16 * (w + 1) + 4 * q) * 2, (u32x2){0u, 0u});
    const int nks = (w + 2) >> 1;
    f32x4 oi[4], oc[4];
#pragma unroll
    for (int et = 0; et < 4; ++et) { oi[et] = (f32x4){0.f, 0.f, 0.f, 0.f}; oc[et] = (f32x4){0.f, 0.f, 0.f, 0.f}; }
    for (int ks = 0; ks < nks; ++ks) {
        const bf16x8 yp = ldsr128(prow + (32 * ks + 8 * q) * 2);
#pragma unroll
        for (int et = 0; et < 4; ++et) oi[et] = mfma16(ldsr128(lds + RVT + (16 * et + r) * TSTR + (32 * ks + 8 * q) * 2), yp, oi[et]);
    }
#pragma unroll
    for (int et = 0; et < 4; ++et) {
        oc[et] = mfma16(ldsr128(lds + RST + (16 * et + r) * RSTR + 16 * q), yq0, oc[et]);
        oc[et] = mfma16(ldsr128(lds + RST + (16 * et + r) * RSTR + 16 * q + 64), yq1, oc[et]);
    }
    const float qd = exp2f(lg2 * (float)(l + 1));
    float ss = 0.f;
#pragma unroll
    for (int et = 0; et < 4; ++et) { oi[et] = oi[et] + oc[et] * qd; ss += (oi[et][0] * oi[et][0] + oi[et][1] * oi[et][1]) + (oi[et][2] * oi[et][2] + oi[et][3] * oi[et][3]); }
    ss += __shfl_xor(ss, 16); ss += __shfl_xor(ss, 32);
    const float rstd = 1.0f / sqrtf(ss * (1.f / 64.f) + EPS);
    const bf16_t* gp = proj + (rowbase + l) * INW + C_GR + h * 64 + 4 * q;
    bf16_t* op = mix + (rowbase + l) * 1024 + h * 64 + 4 * q;
#pragma unroll
    for (int et = 0; et < 4; ++et) {
        const u32x2 gr = *(const u32x2*)(gp + 16 * et);
        const float g0 = bflo(gr.x), g1 = bfhi(gr.x), g2 = bflo(gr.y), g3 = bfhi(gr.y);
        const float s0 = g0 / (1.f + __expf(-g0)), s1 = g1 / (1.f + __expf(-g1)), s2 = g2 / (1.f + __expf(-g2)), s3 = g3 / (1.f + __expf(-g3));
        u32x2 v; v.x = pkbf(oi[et][0] * rstd * s0, oi[et][1] * rstd * s1); v.y = pkbf(oi[et][2] * rstd * s2, oi[et][3] * rstd * s3);
        *(u32x2*)(op + 16 * et) = v;
    }
}
__device__ __forceinline__ float ret_lg2(int h) { return log2f(1.0f - exp2f(-5.0f - (float)h)); }
__device__ __forceinline__ void ret_u_item(lds8* lds, const bf16_t* __restrict__ proj, float* __restrict__ ust, int b, int h, int c) {
    const int tid = threadIdx.x, lane = tid & 63, w = __builtin_amdgcn_readfirstlane(tid >> 6), r = lane & 15, q = lane >> 4;
    ret_stage(lds, proj, (size_t)b * 2048 + 128 * c, h, ret_lg2(h), false);
    __syncthreads();
    f32x4 st[2]; st[0] = (f32x4){0.f, 0.f, 0.f, 0.f}; st[1] = (f32x4){0.f, 0.f, 0.f, 0.f};
    ret_state_update(lds, st, w, r, q, 0.f);
    float* up = ust + ((size_t)((b * 8 + h) * 16 + c) * 16 + w * 2) * 256 + lane * 4;
    *(f32x4*)up = st[0]; *(f32x4*)(up + 256) = st[1];
    __syncthreads();
}
__device__ __forceinline__ void ret_item(lds8* lds, const bf16_t* __restrict__ proj, bf16_t* __restrict__ mix, const float* __restrict__ ust, float* __restrict__ out, int b, int h, int qq) {
    const int tid = threadIdx.x, lane = tid & 63, w = __builtin_amdgcn_readfirstlane(tid >> 6), r = lane & 15, q = lane >> 4;
    const float lg2 = ret_lg2(h), g128 = exp2f(lg2 * 128.f);
    const int et = w >> 1, dt0 = 2 * (w & 1);
    f32x4 st[2]; st[0] = (f32x4){0.f, 0.f, 0.f, 0.f}; st[1] = (f32x4){0.f, 0.f, 0.f, 0.f};
    for (int j = 0; j < 4 * qq; ++j) {
        const float* up = ust + ((size_t)((b * 8 + h) * 16 + j) * 16 + w * 2) * 256 + lane * 4;
        st[0] = st[0] * g128 + *(const f32x4*)up; st[1] = st[1] * g128 + *(const f32x4*)(up + 256);
    }
    for (int cc = 0; cc < 4; ++cc) {
        const size_t rowbase = (size_t)b * 2048 + 128 * (4 * qq + cc);
#pragma unroll
        for (int t = 0; t < 2; ++t)
#pragma unroll
            for (int i = 0; i < 4; ++i) ldsw16(lds + RST + (16 * et + 4 * q + i) * RSTR + (16 * (dt0 + t) + r) * 2, pkbf(st[t][i], 0.f) & 0xffffu);
        ret_stage(lds, proj, rowbase, h, lg2, true);
        __syncthreads();
        ret_chunk_out(lds, proj, mix, rowbase, h, lg2, w, r, q);
        ret_state_update(lds, st, w, r, q, g128);
        __syncthreads();
    }
    if (qq == 3) {
#pragma unroll
        for (int t = 0; t < 2; ++t) *(f32x4*)(out + O_RETP + ((size_t)(b * 8 + h) * 64 + 16 * (dt0 + t) + r) * 64 + 16 * et + 4 * q) = st[t];
    }
}

__device__ __forceinline__ void sample_item(lds8* lds, const bf16_t* __restrict__ proj, bf16_t* __restrict__ mix, float* __restrict__ out, const float* __restrict__ state_ret,
                                            const float* __restrict__ cache_k, const float* __restrict__ cache_v, const float* __restrict__ qg, const float* __restrict__ kg, const float* __restrict__ sinks, int b) {
    const int tid = threadIdx.x, lane = tid & 63, w = __builtin_amdgcn_readfirstlane(tid >> 6);
    LAS float* Kf = (LAS float*)(lds);
    LAS float* Vf = (LAS float*)(lds + 35360);
    LAS float* Qf = (LAS float*)(lds + 70176);
    LAS float* Pf = (LAS float*)(lds + 78368);
    const size_t Rs = (size_t)MP + b * 8;
    for (int kvh = 0; kvh < 2; ++kvh) {
        __syncthreads();
        for (int idx = tid; idx < 2048; idx += 512) {
            const int j = idx >> 4, c4 = idx & 15;
            const size_t src = ((size_t)(b * 128 + j) * 2 + kvh) * 64 + c4 * 4;
            const f32x4 kv = *(const f32x4*)(cache_k + src), vv = *(const f32x4*)(cache_v + src);
            LAS float* kd = Kf + j * 65 + c4 * 4; kd[0] = kv[0]; kd[1] = kv[1]; kd[2] = kv[2]; kd[3] = kv[3];
            *(LAS f32x4*)(Vf + j * 64 + c4 * 4) = vv;
            if (j >= 8) { const size_t dst = ((size_t)(b * 128 + j - 8) * 2 + kvh) * 64 + c4 * 4; *(f32x4*)(out + O_KS + dst) = kv; *(f32x4*)(out + O_VS + dst) = vv; }
        }
        if (tid < 64) {
            const int i = tid >> 3, seg = tid & 7;
            const bf16_t* p = proj + (Rs + i) * INW + C_KS + kvh * 64 + seg * 8;
            float kf[8], vf[8]; unpack8(*(const u32x4*)p, kf); unpack8(*(const u32x4*)(p + 128), vf);
            float ss = 0.f;
#pragma unroll
            for (int e = 0; e < 8; ++e) ss += kf[e] * kf[e];
            ss += __shfl_xor(ss, 1); ss += __shfl_xor(ss, 2); ss += __shfl_xor(ss, 4);
            const float rstd = 1.0f / sqrtf(ss * (1.f / 64.f) + EPS);
            const size_t dst = ((size_t)(b * 128 + 120 + i) * 2 + kvh) * 64 + seg * 8;
#pragma unroll
            for (int e = 0; e < 8; ++e) { kf[e] *= rstd * kg[seg * 8 + e]; Kf[(128 + i) * 65 + seg * 8 + e] = kf[e]; Vf[(128 + i) * 64 + seg * 8 + e] = vf[e]; out[O_KS + dst + e] = kf[e]; out[O_VS + dst + e] = vf[e]; }
        } else if (tid < 320) {
            const int idx = tid - 64, rowq = idx >> 3, seg = idx & 7, g = rowq >> 3, i = rowq & 7;
            const bf16_t* p = proj + (Rs + i) * INW + C_QS + (kvh * 4 + g) * 64 + seg * 8;
            float qf[8]; unpack8(*(const u32x4*)p, qf);
            float ss = 0.f;
#pragma unroll
            for (int e = 0; e < 8; ++e) ss += qf[e] * qf[e];
            ss += __shfl_xor(ss, 1); ss += __shfl_xor(ss, 2); ss += __shfl_xor(ss, 4);
            const float rstd = 0.125f / sqrtf(ss * (1.f / 64.f) + EPS);
#pragma unroll
            for (int e = 0; e < 8; ++e) Qf[rowq * 64 + seg * 8 + e] = qf[e] * rstd * qg[seg * 8 + e];
        }
        __syncthreads();
        for (int rr = 0; rr < 4; ++rr) {
            const int rowq = 4 * w + rr, g = rowq >> 3, i = rowq & 7, head = kvh * 4 + g;
            const float slope = exp2f(-(float)(head + 1)), sink = sinks[head];
            float s[3];
#pragma unroll
            for (int t = 0; t < 3; ++t) {
                const int j = lane + 64 * t; float v = -1e30f;
                if (j < 136) {
                    float dot = 0.f;
#pragma unroll 16
                    for (int d = 0; d < 64; ++d) dot += Qf[rowq * 64 + d] * Kf[j * 65 + d];
                    const int dist = 128 + i - j;
                    if (dist >= 0 && dist < 128) v = dot - slope * (float)dist;
                }
                s[t] = v;
            }
            float mx = wave_max(fmaxf(fmaxf(s[0], s[1]), s[2])); mx = fmaxf(mx, sink);
            float p[3], sum = 0.f;
#pragma unroll
            for (int t = 0; t < 3; ++t) { p[t] = __expf(s[t] - mx); sum += p[t]; }
            sum = wave_sum(sum);
            const float inv = 1.0f / (sum + __expf(sink - mx));
#pragma unroll
            for (int t = 0; t < 3; ++t) { const int j = lane + 64 * t; if (j < 136) Pf[w * 136 + j] = p[t] * inv; }
            float o = 0.f;
#pragma unroll 8
            for (int j = 0; j < 136; ++j) o += Pf[w * 136 + j] * Vf[j * 64 + lane];
            mix[(Rs + i) * 1024 + 512 + head * 64 + lane] = (bf16_t)(pkbf(o, 0.f) & 0xffffu);
        }
    }
    __syncthreads();
    {
        const int h = w;
        LAS float* qf = (LAS float*)(lds + w * 4608); LAS float* kf = qf + 512; LAS float* scl = kf + 512;
        const float lg2 = ret_lg2(h);
        float v[8], gg[8];
#pragma unroll
        for (int l = 0; l < 8; ++l) {
            const bf16_t* p = proj + (Rs + l) * INW + h * 64 + lane;
            qf[l * 64 + lane] = bf2f(p[C_QR]); kf[l * 64 + lane] = 0.125f * bf2f(p[C_KR]); v[l] = bf2f(p[C_VR]); gg[l] = bf2f(p[C_GR]);
        }
        float S[64];
        const float* sp = state_ret + ((size_t)(b * 8 + h) * 64) * 64 + lane;
#pragma unroll
        for (int d = 0; d < 64; ++d) S[d] = sp[d * 64];
        {
            const int l = lane >> 3, m = lane & 7; float dot = 0.f;
#pragma unroll 16
            for (int d = 0; d < 64; ++d) dot += qf[l * 64 + d] * kf[m * 64 + d];
            scl[lane] = (m <= l) ? dot * exp2f(lg2 * (float)(l - m)) : 0.f;
        }
#pragma unroll
        for (int l = 0; l < 8; ++l) {
            float cross = 0.f, intra = 0.f;
#pragma unroll
            for (int d = 0; d < 64; ++d) cross += qf[l * 64 + d] * S[d];
#pragma unroll
            for (int m = 0; m < 8; ++m) intra += scl[l * 8 + m] * v[m];
            const float o = intra + exp2f(lg2 * (float)(l + 1)) * cross;
            const float ss = wave_sum(o * o);
            const float rstd = 1.0f / sqrtf(ss * (1.f / 64.f) + EPS);
            const float gl = gg[l], sil = gl / (1.f + __expf(-gl));
            mix[(Rs + l) * 1024 + h * 64 + lane] = (bf16_t)(pkbf(o * rstd * sil, 0.f) & 0xffffu);
        }
        const float g8 = exp2f(lg2 * 8.f);
        float vk[8];
#pragma unroll
        for (int m = 0; m < 8; ++m) vk[m] = v[m] * exp2f(lg2 * (float)(7 - m));
        float* op = out + O_RETS + ((size_t)(b * 8 + h) * 64) * 64 + lane;
#pragma unroll
        for (int d = 0; d < 64; ++d) {
            float acc = S[d] * g8;
#pragma unroll
            for (int m = 0; m < 8; ++m) acc += kf[m * 64 + d] * vk[m];
            op[d * 64] = acc;
        }
    }
    __syncthreads();
}

#define XB_TMO      128
#define XB_XCNT(j)  (256  + 64 * (j))
#define XB_XSUB(j)  (1280 + 64 * (j))
#define XB_XGEN(j)  (2304 + 64 * (j))
#define XB_TOP      3328
#define XB_TOPGEN   3392
#define XCD_BAR_WORDS 3456
#define XB_SPIN_CAP (1u << 18)

__device__ __forceinline__ unsigned xb_ld(unsigned* p)              { return __hip_atomic_load(p, __ATOMIC_RELAXED, __HIP_MEMORY_SCOPE_AGENT); }
__device__ __forceinline__ unsigned xb_add(unsigned* p, unsigned v) { return __hip_atomic_fetch_add(p, v, __ATOMIC_RELAXED, __HIP_MEMORY_SCOPE_AGENT); }
__device__ __forceinline__ unsigned xb_xcc_id() { return (unsigned)__builtin_amdgcn_s_getreg((3 << 11) | 20) & 0xFu; }
#define XB_SPIN(cond, bar) do { unsigned _sp = 0; while (cond) { __builtin_amdgcn_s_sleep(1); \
    if ((++_sp & 255u) == 0u) { if (xb_ld(&(bar)[XB_TMO])) break; if (_sp > XB_SPIN_CAP) { atomicAdd(&(bar)[XB_TMO], 1u); break; } } } } while (0)

struct XcdBarrier {
    unsigned* bar; unsigned x;
    volatile LAS unsigned* st;
};

__device__ __forceinline__ XcdBarrier xcd_barrier_post(unsigned* bar, volatile LAS unsigned* st) {
    XcdBarrier b; b.bar = bar; b.x = xb_xcc_id(); b.st = st;
    if (threadIdx.x == 0) (void)xb_add(&bar[XB_XCNT(b.x)], 1u);
    return b;
}
__device__ __forceinline__ void xcd_barrier_complete(unsigned* bar, unsigned x, unsigned& nloc, unsigned& nx) {
    const unsigned G = gridDim.x * gridDim.y * gridDim.z;
    unsigned sum, cnt, mine, sp = 0u;
    for (;;) {
        sum = 0u; cnt = 0u; mine = 0u;
#pragma unroll
        for (unsigned j = 0; j < 16; ++j) { const unsigned c = xb_ld(&bar[XB_XCNT(j)]); sum += c; cnt += (c > 0u) ? 1u : 0u; mine = (j == x) ? c : mine; }
        if (sum == G) break;
        __builtin_amdgcn_s_sleep(1);
        if ((++sp & 255u) == 0u) { if (xb_ld(&bar[XB_TMO])) break; if (sp > XB_SPIN_CAP) { atomicAdd(&bar[XB_TMO], 1u); break; } }
    }
    nloc = mine > 0u ? mine : 1u; nx = cnt > 0u ? cnt : 1u;
}

__device__ __forceinline__ void xcd_barrier(const XcdBarrier& b) {
    asm volatile("s_waitcnt vmcnt(0)" ::: "memory");
    __syncthreads();
    if (threadIdx.x == 0) {
        unsigned* bar = b.bar;
        __builtin_amdgcn_s_waitcnt(0);
        unsigned nloc = b.st[0], nx = b.st[1];
        if (nloc == 0u) { xcd_barrier_complete(bar, b.x, nloc, nx); b.st[0] = nloc; b.st[1] = nx; }
        const unsigned old = xb_add(&bar[XB_XSUB(b.x)], 1u);
        const unsigned gen = old / nloc;
        if (old + 1u == (gen + 1u) * nloc) {
            __builtin_amdgcn_fence(__ATOMIC_RELEASE, "agent");
            asm volatile("s_waitcnt vmcnt(0)" ::: "memory");
            const unsigned og = xb_add(&bar[XB_TOP], 1u);
            const unsigned tg = og / nx;
            if (og + 1u == (tg + 1u) * nx) xb_add(&bar[XB_TOPGEN], 1u);
            else XB_SPIN(xb_ld(&bar[XB_TOPGEN]) == tg, bar);
            __builtin_amdgcn_fence(__ATOMIC_ACQUIRE, "agent");
            xb_add(&bar[XB_XGEN(b.x)], 1u);
            asm volatile("s_waitcnt vmcnt(0)" ::: "memory");
        } else {
            XB_SPIN(xb_ld(&bar[XB_XGEN(b.x)]) == gen, bar);
            __builtin_amdgcn_fence(__ATOMIC_ACQUIRE, "agent");
            asm volatile("s_waitcnt vmcnt(0)" ::: "memory");
        }
    }
    __syncthreads();
}

struct Args { const float* in[14]; float* out; unsigned char* ws; };
#ifndef PHM
#define PHM 0x7f
#endif
constexpr int SWA_HS = 2;
constexpr int NI_SWA = 8 * 16 * 2 * (4 / SWA_HS), NI_U = 8 * 8 * 15, NI_SMP = 128, NI_A = NI_SWA + NI_U + NI_SMP;

typedef const __attribute__((address_space(4))) Args* kargs_t;
__device__ __forceinline__ kargs_t argp() { kargs_t p = (kargs_t)__builtin_amdgcn_kernarg_segment_ptr(); asm volatile("" : "+s"(p)); return p; }

__global__ void __launch_bounds__(512, 2) fwd_kernel(Args a_unused) {
    extern __shared__ __attribute__((aligned(16))) unsigned char lds_raw[];
    lds8* lds = (lds8*)lds_raw;
    cg::grid_group grid = cg::this_grid();
    const int tid = threadIdx.x, lane = tid & 63, wave = __builtin_amdgcn_readfirstlane(tid >> 6);
    const int G = gridDim.x, bid = blockIdx.x;
    volatile LAS unsigned* bst = (volatile LAS unsigned*)(lds + LDS_BYTES - 64);
    if (tid < 2) bst[tid] = 0u;
    { kargs_t ap = argp(); unsigned* bw = (unsigned*)(ap->ws + WS_BAR); if (bid == 0) for (int i = tid; i < XCD_BAR_WORDS; i += 512) bw[i] = 0u; }
    __syncthreads();

    if (PHM & 1) {
        kargs_t ap = argp(); unsigned char* ws = ap->ws;
        LAS float* scr = (LAS float*)(lds + wave * 16384);
        const int gw = bid * 8 + wave, NGW = G * 8;
        constexpr int I_IN = (D / 64) * (INW / 32), I_OUT = (D / 64) * (D / 32), I_UP = (D / 64) * (FF / 32), I_DN = (FF / 64) * (D / 32);
        for (int it = gw; it < I_IN + I_OUT + I_UP + I_DN; it += NGW) {
            int r = it;
            if (r < I_IN) { transpose_item(ap->in[6], D, INW, (bf16_t*)(ws + WS_WIN), nullptr, scr, r, lane); continue; } r -= I_IN;
            if (r < I_OUT) { transpose_item(ap->in[10], D, D, (bf16_t*)(ws + WS_WOUT), nullptr, scr, r, lane); continue; } r -= I_OUT;
            if (r < I_UP) { transpose_item(ap->in[12], D, FF, (bf16_t*)(ws + WS_WUP), ap->in[11], scr, r, lane); continue; } r -= I_UP;
            transpose_item(ap->in[13], FF, D, (bf16_t*)(ws + WS_WDN), nullptr, scr, r, lane);
        }
        const float* x_prompt = ap->in[0]; const float* x_sample = ap->in[1]; const float* g_mix = ap->in[5];
        bf16_t* XN = (bf16_t*)(ws + WS_XN);
        for (int m = gw; m < M; m += NGW) {
            const float* xr = (m < MP) ? x_prompt + (size_t)m * D : x_sample + (size_t)(m - MP) * D;
            rms_row_to_bf16(xr, g_mix, XN + (size_t)m * D, lane);
        }
        float* rowss = (float*)(ws + WS_CTL);
        for (int i = bid * 512 + tid; i < M; i += G * 512) rowss[i] = 0.f;
    }
    grid.sync();
    XcdBarrier bar; { kargs_t ap = argp(); bar = xcd_barrier_post((unsigned*)(ap->ws + WS_BAR), bst); }
#define GSYNC() xcd_barrier(bar)

    if (PHM & 2) {
        kargs_t ap = argp(); unsigned char* ws = ap->ws;
        pg8::Gemm g{(const bf16_t*)(ws + WS_XN), (const bf16_t*)(ws + WS_WIN), M, INW, D}; pg8::StaticOrder S; S.init(M, INW, D, G, bid);
        pg8::EpiBf16<0> E{(bf16_t*)(ws + WS_PROJ), INW, nullptr};
        pg8::gemm_phase<pg8::EpiBf16<0>, pg8::StaticOrder, true, true>(lds, g, S, E);
    }
    GSYNC();

#ifdef DUPA
    for (int rep = 0; rep < 2; ++rep) { if (rep) GSYNC();
#endif
    if (PHM & 4) for (int it = bid; it < NI_A; it += G) {
        kargs_t ap = argp(); unsigned char* ws = ap->ws;
        const bf16_t* PROJ = (const bf16_t*)(ws + WS_PROJ);
        if (it < NI_SWA) {
            constexpr int HP = 4 / SWA_HS;
            const int hp = it % HP, kvh = (it / HP) & 1, n = (it / (2 * HP)) & 15, b = it / (32 * HP);
            swa_prompt_item(lds, PROJ, (bf16_t*)(ws + WS_MIX), ap->out, ap->in[7], ap->in[8], ap->in[9], b, n, kvh, hp * SWA_HS, SWA_HS);
        } else if (it < NI_SWA + NI_U) {
            const int r = it - NI_SWA, c = r % 15, h = (r / 15) & 7, b = r / 120;
            ret_u_item(lds, PROJ, (float*)(ws + WS_UST), b, h, c);
        } else {
            sample_item(lds, PROJ, (bf16_t*)(ws + WS_MIX), ap->out, ap->in[2], ap->in[3], ap->in[4], ap->in[7], ap->in[8], ap->in[9], it - NI_SWA - NI_U);
        }
    }
#ifdef DUPA
    }
#endif
    GSYNC();

#ifdef DUPB
    for (int rep = 0; rep < 2; ++rep) { if (rep) GSYNC();
#endif
    if (PHM & 8) for (int it = bid; it < 256; it += G) {
        kargs_t ap = argp(); unsigned char* ws = ap->ws;
        ret_item(lds, (const bf16_t*)(ws + WS_PROJ), (bf16_t*)(ws + WS_MIX), (const float*)(ws + WS_UST), ap->out, it >> 5, (it >> 2) & 7, it & 3);
    }
#ifdef DUPB
    }
#endif
#ifdef XSYNC
    for (int rep = 0; rep < XSYNC; ++rep) GSYNC();
#endif
    GSYNC();

    if (PHM & 16) {
        kargs_t ap = argp(); unsigned char* ws = ap->ws;
        pg8::Gemm g{(const bf16_t*)(ws + WS_MIX), (const bf16_t*)(ws + WS_WOUT), M, D, D}; pg8::StaticOrder S; S.init(M, D, D, G, bid);
        pg8::EpiRes E{ap->in[0], ap->in[1], ap->out, (bf16_t*)(ws + WS_XN), (float*)(ws + WS_CTL)};
        pg8::gemm_phase<pg8::EpiRes, pg8::StaticOrder, true, true>(lds, g, S, E);
    }
    GSYNC();

    if (PHM & 32) {
        kargs_t ap = argp(); unsigned char* ws = ap->ws;
        pg8::Gemm g{(const bf16_t*)(ws + WS_XN), (const bf16_t*)(ws + WS_WUP), M, FF, D}; pg8::StaticOrder S; S.init(M, FF, D, G, bid);
        pg8::EpiBf16<1> E{(bf16_t*)(ws + WS_U), FF, (const float*)(ws + WS_CTL)};
        pg8::gemm_phase<pg8::EpiBf16<1>, pg8::StaticOrder, true, true>(lds, g, S, E);
    }
    GSYNC();

    if (PHM & 64) {
        kargs_t ap = argp(); unsigned char* ws = ap->ws;
        pg8::Gemm g{(const bf16_t*)(ws + WS_U), (const bf16_t*)(ws + WS_WDN), M, D, FF}; pg8::DownOrder S; S.init(FF, G, bid);
        pg8::EpiDown E{ap->out, (float*)(ws + WS_PART)};
        pg8::gemm_phase<pg8::EpiDown, pg8::DownOrder, true, true>(lds, g, S, E);
    }
    GSYNC();
    if (PHM & 64) {
        kargs_t ap = argp(); const f32x4* part = (const f32x4*)(ap->ws + WS_PART); f32x4* ys = (f32x4*)(ap->out + (size_t)MP * D);
        for (int i = bid * 512 + tid; i < MS * D / 4; i += G * 512) {
            f32x4 v = ys[i];
#pragma unroll
            for (int sidx = 0; sidx < pg8::DN_SLICES; ++sidx) v = v + part[(size_t)sidx * (MS * D / 4) + i];
            ys[i] = v;
        }
    }
}

extern "C" void kernel_launch(void* const* d_in, const int* in_sizes, int n_in, void* d_out, int out_size, void* d_ws, size_t ws_size, hipStream_t stream) {
    static int grid = 0;
    if (grid == 0) {
        int dev = 0, cus = 0, per_cu = 0;
        (void)hipGetDevice(&dev);
        (void)hipDeviceGetAttribute(&cus, hipDeviceAttributeMultiprocessorCount, dev);
        if (hipFuncSetAttribute((const void*)fwd_kernel, hipFuncAttributeMaxDynamicSharedMemorySize, LDS_BYTES) != hipSuccess) fprintf(stderr, "kernel_launch: hipFuncSetAttribute failed\n");
        if (hipOccupancyMaxActiveBlocksPerMultiprocessor(&per_cu, (const void*)fwd_kernel, 512, LDS_BYTES) != hipSuccess || per_cu < 1) per_cu = 1;
        (void)hipGetLastError();
        if (cus <= 0) cus = 256;
        grid = cus * per_cu;
    }
    Args a{};
    for (int i = 0; i < 14; ++i) a.in[i] = (const float*)d_in[i];
    a.out = (float*)d_out; a.ws = (unsigned char*)d_ws;
    void* params[] = {&a};
    hipError_t e = hipLaunchCooperativeKernel((const void*)fwd_kernel, dim3(grid), dim3(512), params, LDS_BYTES, stream);
    if (e != hipSuccess) fprintf(stderr, "kernel_launch: cooperative launch failed: %s (grid %d)\n", hipGetErrorString(e), grid);
}
```

```cpp
#include <hip/hip_runtime.h>
#include <hip/hip_cooperative_groups.h>
#include <cstdio>
#include <cstdint>
namespace cg = cooperative_groups;
namespace pg8 {
#define PG8_LAS __attribute__((address_space(3)))
typedef unsigned short bf16_t;
typedef short bf16x8 __attribute__((ext_vector_type(8)));
typedef float f32x4 __attribute__((ext_vector_type(4)));
typedef unsigned u32x4 __attribute__((ext_vector_type(4)));
constexpr int BM = 256, BK = 64, HALF = 128, HTB = HALF * BK * 2  , STAGE_BYTES = 8 * HTB, NXCD = 8, WGM = 8;

__host__ __device__ __forceinline__ int lds_byte(int r, int c) { const int st = (r >> 4) * 2 + (c >> 5), rr = r & 15, cc = c & 31, ob = rr * 64 + cc * 2; return st * 1024 + (ob ^ (((ob >> 9) & 1) << 5)); }
__host__ __device__ __forceinline__ void stage_rc(int b, int& R, int& C) { const int st = b / 1024, sb = b % 1024, swz = sb ^ (((sb >> 9) & 1) << 5); R = (st >> 1) * 16 + swz / 64; C = (st & 1) * 32 + (swz % 64) / 2; }
__host__ __device__ __forceinline__ int perm32(int rho) { const int n = rho >> 4, i = rho & 15; return 8 * (i >> 2) + 4 * n + (i & 3); }

struct Unit { int pm, pn, k0, nt; };
struct Gemm { const bf16_t* A; const bf16_t* Bt; int M, N, K; };

struct StaticOrder {
    int nM, nN, nwg, G, c, ntk;
    __host__ __device__ void init(int M, int N, int K, int G_, int c_) { nM = M / BM; nN = N / BM; nwg = nM * nN; G = G_; c = c_; ntk = K / BK; }
    __host__ __device__ bool next(int i, Unit& u) const { return at((long)i * G + c, u); }
    __host__ __device__ bool at(long L, Unit& u) const {
        if (L < 0 || L >= nwg) return false;
        int wgid = (int)L; { const int q = nwg / NXCD, r = nwg % NXCD, xcd = wgid % NXCD, off = wgid / NXCD; wgid = (xcd < r ? xcd * (q + 1) : r * (q + 1) + (xcd - r) * q) + off; }
        const int nig = WGM * nN, gid = wgid / nig, fm = gid * WGM, gsz = (nM - fm) < WGM ? (nM - fm) : WGM;
        u.pm = fm + ((wgid % nig) % gsz); u.pn = (wgid % nig) / gsz; u.k0 = 0; u.nt = ntk; return true;
    }
    __device__ __forceinline__ void a_ready(const Unit&) const {}
    __device__ __forceinline__ void done(const Unit&) const {}
};

__device__ __forceinline__ unsigned cvt_pk_bf16(float lo, float hi) { unsigned r; asm volatile("v_cvt_pk_bf16_f32 %0, %1, %2" : "=v"(r) : "v"(lo), "v"(hi)); return r; }
typedef float f32x2 __attribute__((ext_vector_type(2)));
typedef unsigned u32x2 __attribute__((ext_vector_type(2)));
constexpr int MROWS_PROMPT = 16384;
constexpr float RMS_EPS = 1e-6f;

template <int MODE> struct EpiBf16 {
    static constexpr bool PERM = true, AFTER_DRAIN = false;
    bf16_t* O; int ldc; const float* rowss;
    __device__ __forceinline__ void operator()(const f32x4 (&acc)[2][2][4][2], const Unit& u, int wr, int wc, int fr, int fq) const {
        const int row0 = u.pm * BM + wr * 64 + fr, col0 = u.pn * BM + wc * 32 + 8 * fq;
#pragma unroll
        for (int ai = 0; ai < 2; ++ai)
#pragma unroll
            for (int m = 0; m < 4; ++m) {
                const int row = row0 + ai * HALF + m * 16;
                float sc = 1.f;
                if (MODE == 1) sc = __builtin_amdgcn_rsqf(rowss[row] * (1.0f / 1024.0f) + RMS_EPS);
                bf16_t* rowp = O + (size_t)row * ldc + col0;
#pragma unroll
                for (int bj = 0; bj < 2; ++bj) {
                    f32x4 v0 = acc[ai][bj][m][0], v1 = acc[ai][bj][m][1];
                    if (MODE == 1) {
                        v0 = v0 * sc; v1 = v1 * sc;
#pragma unroll
                        for (int e = 0; e < 4; ++e) { const float a = fmaxf(v0[e], 0.f), b = fmaxf(v1[e], 0.f); v0[e] = a * a; v1[e] = b * b; }
                    }
                    u32x4 w; w.x = cvt_pk_bf16(v0[0], v0[1]); w.y = cvt_pk_bf16(v0[2], v0[3]); w.z = cvt_pk_bf16(v1[0], v1[1]); w.w = cvt_pk_bf16(v1[2], v1[3]);
                    *(u32x4*)(rowp + bj * HALF) = w;
                }
            }
    }
};

struct EpiRes {
    static constexpr bool PERM = false, AFTER_DRAIN = false;
    const float* xp; const float* xs; float* out; bf16_t* hb; float* rowss;
    __device__ __forceinline__ void operator()(const f32x4 (&acc)[2][2][4][2], const Unit& u, int wr, int wc, int fr, int fq) const {
        const int row0 = u.pm * BM + wr * 64 + fr, col0 = u.pn * BM + wc * 32 + 4 * fq;
#pragma unroll
        for (int ai = 0; ai < 2; ++ai)
#pragma unroll
            for (int m = 0; m < 4; ++m) {
                const int row = row0 + ai * HALF + m * 16;
                const float* xrow = (row < MROWS_PROMPT) ? xp + (size_t)row * 1024 : xs + (size_t)(row - MROWS_PROMPT) * 1024;
                float ss = 0.f;
#pragma unroll
                for (int bj = 0; bj < 2; ++bj)
#pragma unroll
                    for (int n = 0; n < 2; ++n) {
                        const int col = col0 + bj * HALF + n * 16;
                        const f32x4 h = *(const f32x4*)(xrow + col) + acc[ai][bj][m][n];
                        *(f32x4*)(out + (size_t)row * 1024 + col) = h;
                        ss += (h[0] * h[0] + h[1] * h[1]) + (h[2] * h[2] + h[3] * h[3]);
                        u32x2 w; w.x = cvt_pk_bf16(h[0], h[1]); w.y = cvt_pk_bf16(h[2], h[3]);
                        *(u32x2*)(hb + (size_t)row * 1024 + col) = w;
                    }
                ss += __shfl_xor(ss, 16); ss += __shfl_xor(ss, 32);
                if (fq == 0) __hip_atomic_fetch_add(rowss + row, ss, __ATOMIC_RELAXED, __HIP_MEMORY_SCOPE_AGENT);
            }
    }
};

constexpr int DN_SLICES = 8, DN_UNITS = 16 * DN_SLICES;
struct DownOrder {
    StaticOrder so; int G, c;
    __host__ __device__ void init(int K, int G_, int c_) { so.init(MROWS_PROMPT, 1024, K, G_, c_); G = G_; c = c_; }
    __host__ __device__ bool next(int i, Unit& u) const {
        const long L = (long)i * G + c;
        if (L >= DN_UNITS) return so.at(L - DN_UNITS, u);
        const int tile = (int)L / DN_SLICES, slice = (int)L % DN_SLICES;
        u.pm = 64 + (tile >> 2); u.pn = tile & 3; u.k0 = slice * (4096 / DN_SLICES); u.nt = 64 / DN_SLICES; return true;
    }
    __device__ __forceinline__ void a_ready(const Unit&) const {}
    __device__ __forceinline__ void done(const Unit&) const {}
};
struct EpiDown {
    static constexpr bool PERM = false, AFTER_DRAIN = false;
    float* out; float* part;
    __device__ __forceinline__ void operator()(const f32x4 (&acc)[2][2][4][2], const Unit& u, int wr, int wc, int fr, int fq) const {
        const int row0 = u.pm * BM + wr * 64 + fr, col0 = u.pn * BM + wc * 32 + 4 * fq;
        const bool sl = u.pm >= 64;
        float* base = sl ? part + ((size_t)(u.k0 / (4096 / DN_SLICES)) * 1024 - MROWS_PROMPT) * 1024 : out;
#pragma unroll
        for (int ai = 0; ai < 2; ++ai)
#pragma unroll
            for (int m = 0; m < 4; ++m) {
                float* orow = base + (size_t)(row0 + ai * HALF + m * 16) * 1024 + col0;
#pragma unroll
                for (int bj = 0; bj < 2; ++bj)
#pragma unroll
                    for (int n = 0; n < 2; ++n) { float* p = orow + bj * HALF + n * 16; const f32x4 v = acc[ai][bj][m][n];
                        if (sl) *(f32x4*)p = v; else *(f32x4*)p = *(const f32x4*)p + v; }
            }
    }
};
template <class Epi, class Sched, bool ALIGN_EPI = false, bool SP2 = false>
__device__ __forceinline__ void gemm_phase(PG8_LAS unsigned char* lds, const Gemm g, const Sched& S, const Epi& E) {
    const int tid = threadIdx.x, wid = __builtin_amdgcn_readfirstlane(tid >> 6), lane = tid & 63, wr = wid >> 2, wc = wid & 3, fr = lane & 15, fq = lane >> 4;
    const int K = g.K;
    unsigned voffA[2], voffB[2];
#pragma unroll
    for (int i = 0; i < 2; ++i) { int R, C; stage_rc(tid * 16 + i * 8192, R, C); const int Rb = Epi::PERM ? ((R & ~31) + perm32(R & 31)) : R;
        voffA[i] = (unsigned)(R * K + C) * 2u; voffB[i] = (unsigned)(Rb * K + C) * 2u; }
    const size_t kstep = (size_t)(BK * 2);
    const size_t hstep = (size_t)HALF * K * 2;
    const size_t tstep = 2 * hstep;
    const unsigned ldsw = (unsigned)wid * 1024u;
    const int aoff = lds_byte(wr * 64 + fr, fq * 8), boff = lds_byte(wc * 32 + fr, fq * 8);
#define PG8_SA(b, h) (((b) * 2 + (h)) * HTB)
#define PG8_SB(b, h) ((4 + (b) * 2 + (h)) * HTB)
#define PG8_STAGE(bufoff, gbase, voff) do { _Pragma("unroll") for (int _i = 0; _i < 2; ++_i) \
        __builtin_amdgcn_global_load_lds((const unsigned*)((const char*)(gbase) + (voff)[_i]), (PG8_LAS unsigned*)(lds + (bufoff) + ldsw + _i * 8192), 16, 0, 0); } while (0)
#define PG8_LDA(dst, b, h) do { _Pragma("unroll") for (int m = 0; m < 4; ++m) _Pragma("unroll") for (int k = 0; k < 2; ++k) dst[m][k] = *(const PG8_LAS bf16x8*)(lds + PG8_SA(b, h) + aoff + m * 2048 + k * 1024); } while (0)
#define PG8_LDB(dst, b, h) do { _Pragma("unroll") for (int n = 0; n < 2; ++n) _Pragma("unroll") for (int k = 0; k < 2; ++k) dst[n][k] = *(const PG8_LAS bf16x8*)(lds + PG8_SB(b, h) + boff + n * 2048 + k * 1024); } while (0)
#define PG8_MMA(ai, bj, At, Bt) do { __builtin_amdgcn_s_setprio(1); _Pragma("unroll") for (int m = 0; m < 4; ++m) _Pragma("unroll") for (int n = 0; n < 2; ++n) _Pragma("unroll") for (int k = 0; k < 2; ++k) \
        acc[ai][bj][m][n] = __builtin_amdgcn_mfma_f32_16x16x32_bf16(Bt[n][k], At[m][k], acc[ai][bj][m][n], 0, 0, 0); __builtin_amdgcn_s_setprio(0); } while (0)
#define PG8_WAIT_V(n) asm volatile("s_waitcnt vmcnt(" #n ")" ::: "memory")
#define PG8_WAIT_L(n) asm volatile("s_waitcnt lgkmcnt(" #n ")" ::: "memory")
#define PG8_BAR __builtin_amdgcn_s_barrier()
#define PG8_SCHED __builtin_amdgcn_sched_barrier(0)
    Unit cur, nxt; int ui = 0;
    if (!S.next(0, cur)) return;
    f32x4 acc[2][2][4][2];
#pragma unroll
    for (int a = 0; a < 2; ++a)
#pragma unroll
        for (int b = 0; b < 2; ++b)
#pragma unroll
            for (int m = 0; m < 4; ++m)
#pragma unroll
                for (int n = 0; n < 2; ++n) acc[a][b][m][n] = (f32x4){0.f, 0.f, 0.f, 0.f};
    bf16x8 At[4][2], B0[2][2], B1[2][2];
    const char* cA = (const char*)g.A + (size_t)cur.pm * tstep + (size_t)cur.k0 * 2; const char* cB = (const char*)g.Bt + (size_t)cur.pn * tstep + (size_t)cur.k0 * 2;
    S.a_ready(cur);
    if constexpr (SP2) {
        PG8_STAGE(PG8_SB(0, 0), cB, voffB); PG8_STAGE(PG8_SB(0, 1), cB + hstep, voffB); PG8_STAGE(PG8_SA(0, 0), cA, voffA); PG8_STAGE(PG8_SA(0, 1), cA + hstep, voffA);
        if (wr == 1) PG8_BAR;
        PG8_WAIT_V(2); PG8_BAR;
        PG8_STAGE(PG8_SB(1, 0), cB + kstep, voffB); PG8_STAGE(PG8_SA(1, 0), cA + kstep, voffA); PG8_STAGE(PG8_SB(1, 1), cB + hstep + kstep, voffB);
        PG8_WAIT_V(6); PG8_BAR;
    } else {
        PG8_STAGE(PG8_SB(0, 0), cB, voffB); PG8_STAGE(PG8_SA(0, 0), cA, voffA); PG8_STAGE(PG8_SB(0, 1), cB + hstep, voffB); PG8_STAGE(PG8_SA(0, 1), cA + hstep, voffA);
        if (wr == 1) PG8_BAR;
        PG8_WAIT_V(4); PG8_BAR;
        PG8_STAGE(PG8_SB(1, 0), cB + kstep, voffB); PG8_STAGE(PG8_SA(1, 0), cA + kstep, voffA); PG8_STAGE(PG8_SB(1, 1), cB + hstep + kstep, voffB);
        PG8_WAIT_V(6); PG8_BAR;
    }
    for (;;) {
        const bool has_next = S.next(ui + 1, nxt);
        const char* nA = has_next ? (const char*)g.A + (size_t)nxt.pm * tstep + (size_t)nxt.k0 * 2 : cA; const char* nB = has_next ? (const char*)g.Bt + (size_t)nxt.pn * tstep + (size_t)nxt.k0 * 2 : cB;
        const int nt = cur.nt;
        for (int t = 0; t < nt; t += 2) {
            const bool last = (t == nt - 2);
            const char* a1 = cA + (size_t)(t + 1) * kstep;
            const char* a2 = last ? nA : cA + (size_t)(t + 2) * kstep; const char* b2 = last ? nB : cB + (size_t)(t + 2) * kstep;
            const char* a3 = a2 + kstep; const char* b3 = b2 + kstep;
            if (last && has_next) S.a_ready(nxt);
            if constexpr (SP2) {
            PG8_LDB(B0, 0, 0); PG8_LDB(B1, 0, 1); PG8_SCHED; PG8_LDA(At, 0, 0); PG8_STAGE(PG8_SA(1, 1), a1 + hstep, voffA);
            PG8_WAIT_V(8); PG8_WAIT_L(0); PG8_BAR; PG8_MMA(0, 0, At, B0); PG8_MMA(0, 1, At, B1); PG8_BAR; PG8_SCHED;
            PG8_LDA(At, 0, 1); PG8_STAGE(PG8_SB(0, 0), b2, voffB); PG8_STAGE(PG8_SB(0, 1), b2 + hstep, voffB); PG8_STAGE(PG8_SA(0, 0), a2, voffA);
            PG8_WAIT_V(8); PG8_WAIT_L(0); PG8_BAR; PG8_MMA(1, 0, At, B0); PG8_MMA(1, 1, At, B1); PG8_BAR; PG8_SCHED;
            PG8_LDB(B0, 1, 0); PG8_LDB(B1, 1, 1); PG8_SCHED; PG8_LDA(At, 1, 0); PG8_STAGE(PG8_SA(0, 1), a2 + hstep, voffA);
            PG8_WAIT_V(8); PG8_WAIT_L(0); PG8_BAR; PG8_MMA(0, 0, At, B0); PG8_MMA(0, 1, At, B1); PG8_BAR; PG8_SCHED;
            PG8_LDA(At, 1, 1); PG8_STAGE(PG8_SB(1, 0), b3, voffB); PG8_STAGE(PG8_SB(1, 1), b3 + hstep, voffB); PG8_STAGE(PG8_SA(1, 0), a3, voffA);
            PG8_WAIT_V(8); PG8_WAIT_L(0); PG8_BAR; PG8_MMA(1, 0, At, B0); PG8_MMA(1, 1, At, B1); PG8_BAR; PG8_SCHED;
            } else {
            PG8_LDB(B0, 0, 0); PG8_SCHED; PG8_LDA(At, 0, 0); PG8_STAGE(PG8_SA(1, 1), a1 + hstep, voffA);
            PG8_WAIT_L(8); PG8_BAR; PG8_WAIT_L(0); PG8_MMA(0, 0, At, B0); PG8_BAR; PG8_SCHED;
            PG8_LDB(B1, 0, 1); PG8_STAGE(PG8_SB(0, 0), b2, voffB);
            PG8_BAR; PG8_WAIT_L(0); PG8_MMA(0, 1, At, B1); PG8_BAR;
            PG8_LDA(At, 0, 1); PG8_STAGE(PG8_SA(0, 0), a2, voffA);
            PG8_BAR; PG8_WAIT_L(0); PG8_MMA(1, 0, At, B0); PG8_BAR; PG8_SCHED;
            PG8_STAGE(PG8_SB(0, 1), b2 + hstep, voffB);
            PG8_WAIT_V(6); PG8_BAR; PG8_MMA(1, 1, At, B1); PG8_BAR;
            PG8_LDB(B0, 1, 0); PG8_SCHED; PG8_LDA(At, 1, 0); PG8_STAGE(PG8_SA(0, 1), a2 + hstep, voffA);
            PG8_WAIT_L(8); PG8_BAR; PG8_WAIT_L(0); PG8_MMA(0, 0, At, B0); PG8_BAR; PG8_SCHED;
            PG8_LDB(B1, 1, 1); PG8_STAGE(PG8_SB(1, 0), b3, voffB);
            PG8_BAR; PG8_WAIT_L(0); PG8_MMA(0, 1, At, B1); PG8_BAR;
            PG8_LDA(At, 1, 1); PG8_STAGE(PG8_SA(1, 0), a3, voffA);
            PG8_BAR; PG8_WAIT_L(0); PG8_MMA(1, 0, At, B0); PG8_BAR; PG8_SCHED;
            PG8_STAGE(PG8_SB(1, 1), b3 + hstep, voffB);
            PG8_WAIT_V(6); PG8_BAR; PG8_MMA(1, 1, At, B1); PG8_BAR;
            }
        }
        if constexpr (ALIGN_EPI) { if (wr == 0) PG8_BAR; }
        if constexpr (!Epi::AFTER_DRAIN) { E(acc, cur, wr, wc, fr, fq); S.done(cur); }
        if (!has_next) break;
#pragma unroll
        for (int a = 0; a < 2; ++a)
#pragma unroll
            for (int b = 0; b < 2; ++b)
#pragma unroll
                for (int m = 0; m < 4; ++m)
#pragma unroll
                    for (int n = 0; n < 2; ++n) acc[a][b][m][n] = (f32x4){0.f, 0.f, 0.f, 0.f};
        cur = nxt; cA = nA; cB = nB; ++ui;
        if constexpr (ALIGN_EPI) { if (wr == 1) PG8_BAR; }
    }
    PG8_WAIT_V(0);
    if constexpr (!ALIGN_EPI) { if (wr == 0) PG8_BAR; }
    PG8_BAR;
    if constexpr (Epi::AFTER_DRAIN) { E.fused(acc, cur, wr, wc, fr, fq, lds, wid, lane); S.done(cur); }
#undef PG8_SA
#undef PG8_SB
#undef PG8_STAGE
#undef PG8_LDA
#undef PG8_LDB
#undef PG8_MMA
#undef PG8_WAIT_V
#undef PG8_WAIT_L
#undef PG8_BAR
#undef PG8_SCHED
}
}
#define LAS __attribute__((address_space(3)))
typedef unsigned short bf16_t;
typedef short bf16x8 __attribute__((ext_vector_type(8)));
typedef float f32x4 __attribute__((ext_vector_type(4)));
typedef unsigned u32x4 __attribute__((ext_vector_type(4)));
typedef unsigned u32x2 __attribute__((ext_vector_type(2)));
typedef LAS unsigned char lds8;

constexpr int D = 1024, INW = 2816, FF = 4096;
constexpr int MP = 16384, MS = 1024, M = MP + MS;
constexpr int C_QR = 0, C_KR = 512, C_VR = 1024, C_GR = 1536, C_QS = 2048, C_KS = 2560, C_VS = 2688;
constexpr size_t O_RETP = 17825792, O_KP = 18087936, O_VP = 18219008, O_RETS = 18350080, O_KS = 22544384, O_VS = 24641536;
constexpr size_t MiB = 1u << 20;
constexpr size_t WS_CTL = 0, WS_WIN = 1 * MiB, WS_WOUT = 7 * MiB, WS_WUP = 9 * MiB, WS_WDN = 17 * MiB;
constexpr size_t WS_XN = 25 * MiB;
constexpr size_t WS_PROJ = 59 * MiB;
constexpr size_t WS_MIX = 153 * MiB;
constexpr size_t WS_U = 59 * MiB;
constexpr size_t WS_UST = 196 * MiB;
constexpr size_t WS_PART = 212 * MiB;
constexpr size_t WS_BAR = 131072;
constexpr int LDS_BYTES = 147456;
constexpr float EPS = 1e-6f, LOG2E = 1.4426950408889634f;

typedef float f32x2_t __attribute__((ext_vector_type(2))); typedef __bf16 bf16x2_t __attribute__((ext_vector_type(2)));
__device__ __forceinline__ unsigned pkbf(float lo, float hi) { const f32x2_t v = {lo, hi}; const bf16x2_t b = __builtin_convertvector(v, bf16x2_t); return __builtin_bit_cast(unsigned, b); }
__device__ __forceinline__ float bflo(unsigned u) { return __uint_as_float(u << 16); }
__device__ __forceinline__ float bfhi(unsigned u) { return __uint_as_float(u & 0xffff0000u); }
__device__ __forceinline__ float bf2f(bf16_t h) { return __uint_as_float((unsigned)h << 16); }
__device__ __forceinline__ void unpack8(const u32x4 v, float (&f)[8]) { f[0] = bflo(v.x); f[1] = bfhi(v.x); f[2] = bflo(v.y); f[3] = bfhi(v.y); f[4] = bflo(v.z); f[5] = bfhi(v.z); f[6] = bflo(v.w); f[7] = bfhi(v.w); }
__device__ __forceinline__ u32x4 pack8(const float (&f)[8]) { u32x4 o; o.x = pkbf(f[0], f[1]); o.y = pkbf(f[2], f[3]); o.z = pkbf(f[4], f[5]); o.w = pkbf(f[6], f[7]); return o; }
__device__ __forceinline__ bf16x8 ldsr128(const lds8* p) { return *(const LAS bf16x8*)p; }
__device__ __forceinline__ void ldsw128(lds8* p, u32x4 v) { *(LAS u32x4*)p = v; }
__device__ __forceinline__ void ldsw64(lds8* p, u32x2 v) { *(LAS u32x2*)p = v; }
__device__ __forceinline__ void ldsw16(lds8* p, unsigned v) { *(LAS unsigned short*)p = (unsigned short)v; }
__device__ __forceinline__ f32x4 mfma16(bf16x8 a, bf16x8 b, f32x4 c) { return __builtin_amdgcn_mfma_f32_16x16x32_bf16(a, b, c, 0, 0, 0); }
__device__ __forceinline__ float wave_sum(float v) {
#pragma unroll
    for (int o = 1; o < 64; o <<= 1) v += __shfl_xor(v, o);
    return v;
}
__device__ __forceinline__ float wave_max(float v) {
#pragma unroll
    for (int o = 1; o < 64; o <<= 1) v = fmaxf(v, __shfl_xor(v, o));
    return v;
}
__device__ __forceinline__ float ex2(float x) { return __builtin_amdgcn_exp2f(x); }
typedef short s16x4 __attribute__((ext_vector_type(4)));
constexpr int TRS = 144;
__device__ __forceinline__ int tr_off(int lane) { return (8 * (lane >> 4) + ((lane & 15) >> 2)) * TRS + 8 * (lane & 3); }
__device__ __forceinline__ bf16x8 ldstr(const lds8* tile  , int troff) {
    const s16x4 lo = __builtin_amdgcn_ds_read_tr16_b64_v4i16((LAS s16x4*)(tile + troff));
    const s16x4 hi = __builtin_amdgcn_ds_read_tr16_b64_v4i16((LAS s16x4*)(tile + troff + 4 * TRS));
    return (bf16x8){lo[0], lo[1], lo[2], lo[3], hi[0], hi[1], hi[2], hi[3]};
}

__device__ __forceinline__ void transpose_item(const float* __restrict__ W, int K, int N, bf16_t* __restrict__ WT, const float* __restrict__ gain, LAS float* scr, int item, int lane) {
    const int nblk = N / 32, kb = item / nblk, nb = item % nblk, k0 = 64 * kb, n0 = 32 * nb;
#pragma unroll 8
    for (int i = 0; i < 32; ++i) { const int kk = 2 * i + (lane >> 5); const float g = gain ? gain[k0 + kk] : 1.f; scr[kk * 33 + (lane & 31)] = W[(size_t)(k0 + kk) * N + n0 + (lane & 31)] * g; }
    asm volatile("s_waitcnt lgkmcnt(0)" ::: "memory");
    const int c = lane & 7;
#pragma unroll
    for (int j = 0; j < 4; ++j) { const int n = (lane >> 3) + 8 * j; const LAS float* s = scr + (8 * c) * 33 + n;
        u32x4 o; o.x = pkbf(s[0 * 33], s[1 * 33]); o.y = pkbf(s[2 * 33], s[3 * 33]); o.z = pkbf(s[4 * 33], s[5 * 33]); o.w = pkbf(s[6 * 33], s[7 * 33]);
        *(u32x4*)(WT + (size_t)(n0 + n) * K + k0 + 8 * c) = o; }
    asm volatile("s_waitcnt lgkmcnt(0)" ::: "memory");
}
__device__ __forceinline__ void rms_row_to_bf16(const float* __restrict__ xrow, const float* __restrict__ gain, bf16_t* __restrict__ orow, int lane) {
    const f32x4* xr = (const f32x4*)xrow + lane; const f32x4* gr = (const f32x4*)gain + lane;
    f32x4 v[4]; float s = 0.f;
#pragma unroll
    for (int j = 0; j < 4; ++j) { v[j] = xr[64 * j]; s += (v[j].x * v[j].x + v[j].y * v[j].y) + (v[j].z * v[j].z + v[j].w * v[j].w); }
    const float rstd = 1.0f / sqrtf(wave_sum(s) * (1.f / D) + EPS);
    u32x2* o8 = (u32x2*)orow + lane;
#pragma unroll
    for (int j = 0; j < 4; ++j) { const f32x4 g = gr[64 * j]; u32x2 o; o.x = pkbf(v[j].x * rstd * g.x, v[j].y * rstd * g.y); o.y = pkbf(v[j].z * rstd * g.z, v[j].w * rstd * g.w); o8[64 * j] = o; }
}

__device__ __forceinline__ void swa_prompt_item(lds8* lds, const bf16_t* __restrict__ proj, bf16_t* __restrict__ mix, float* __restrict__ out,
                                                const float* __restrict__ qg, const float* __restrict__ kg, const float* __restrict__ sinks, int b, int n, int kvh, int h0, int nh) {
    const int tid = threadIdx.x, lane = tid & 63, w = __builtin_amdgcn_readfirstlane(tid >> 6), r = lane & 15, q = lane >> 4;
    constexpr int KS = 0, KSTR = 144, VS = 36864, QS = 73728, QSTR = 144, PS = 92160, PSTR = 336, PWAVE = 5376;
    const int troff = tr_off(lane);
    const size_t rowb = (size_t)b * 2048;
    for (int idx = tid; idx < 2048; idx += 512) {
        const int row = idx >> 3, seg = idx & 7, t = (n - 1) * 128 + row;
        float kf[8]; u32x4 vr = (u32x4){0u, 0u, 0u, 0u};
        if (t >= 0) { const bf16_t* p = proj + (rowb + t) * INW + C_KS + kvh * 64 + seg * 8; const u32x4 kr = *(const u32x4*)p; vr = *(const u32x4*)(p + 128); unpack8(kr, kf); }
        else {
#pragma unroll
            for (int e = 0; e < 8; ++e) kf[e] = 0.f; }
        float ss = 0.f;
#pragma unroll
        for (int e = 0; e < 8; ++e) ss += kf[e] * kf[e];
        ss += __shfl_xor(ss, 1); ss += __shfl_xor(ss, 2); ss += __shfl_xor(ss, 4);
        const float rstd = 1.0f / sqrtf(ss * (1.f / 64.f) + EPS);
#pragma unroll
        for (int e = 0; e < 8; ++e) kf[e] *= rstd * kg[seg * 8 + e];
        ldsw128(lds + KS + row * KSTR + seg * 16, pack8(kf));
        ldsw128(lds + VS + row * TRS + seg * 16, vr);
        if (n == 15 && h0 == 0 && row >= 128) {
            const size_t dst = ((size_t)(b * 128 + row - 128) * 2 + kvh) * 64 + seg * 8;
            float vf[8]; unpack8(vr, vf);
            *(f32x4*)(out + O_KP + dst) = (f32x4){kf[0], kf[1], kf[2], kf[3]}; *(f32x4*)(out + O_KP + dst + 4) = (f32x4){kf[4], kf[5], kf[6], kf[7]};
            *(f32x4*)(out + O_VP + dst) = (f32x4){vf[0], vf[1], vf[2], vf[3]}; *(f32x4*)(out + O_VP + dst + 4) = (f32x4){vf[4], vf[5], vf[6], vf[7]};
        }
    }
    for (int hh = h0; hh < h0 + nh; ++hh) {
        const int head = kvh * 4 + hh;
        __syncthreads();
        for (int idx = tid; idx < 1024; idx += 512) {
            const int row = idx >> 3, seg = idx & 7;
            const bf16_t* p = proj + (rowb + n * 128 + row) * INW + C_QS + head * 64 + seg * 8;
            float qf[8]; unpack8(*(const u32x4*)p, qf);
            float ss = 0.f;
#pragma unroll
            for (int e = 0; e < 8; ++e) ss += qf[e] * qf[e];
            ss += __shfl_xor(ss, 1); ss += __shfl_xor(ss, 2); ss += __shfl_xor(ss, 4);
            const float rstd = (0.125f * LOG2E) / sqrtf(ss * (1.f / 64.f) + EPS);
#pragma unroll
            for (int e = 0; e < 8; ++e) qf[e] *= rstd * qg[seg * 8 + e];
            ldsw128(lds + QS + row * QSTR + seg * 16, pack8(qf));
        }
        __syncthreads();
        const float slope2 = exp2f(-(float)(head + 1)) * LOG2E, sink2 = sinks[head] * LOG2E;
        const bf16x8 yq0 = ldsr128(lds + QS + (16 * w + r) * QSTR + 16 * q), yq1 = ldsr128(lds + QS + (16 * w + r) * QSTR + 16 * q + 64);
        f32x4 sc[9];
#pragma unroll
        for (int j = 0; j < 9; ++j) {
            const lds8* kp = lds + KS + (16 * (w + j) + r) * KSTR + 16 * q;
            sc[j] = mfma16(ldsr128(kp), yq0, (f32x4){0.f, 0.f, 0.f, 0.f});
            sc[j] = mfma16(ldsr128(kp + 64), yq1, sc[j]);
        }
        const int qi = 16 * w + r;
        float mx = sink2;
#pragma unroll
        for (int j = 0; j < 9; ++j)
#pragma unroll
            for (int i = 0; i < 4; ++i) {
                const int key = 16 * (w + j) + 4 * q + i, dist = 128 + qi - key;
                const bool valid = (dist >= 0) && (dist < 128) && (n > 0 || key >= 128);
                const float v = valid ? sc[j][i] - slope2 * (float)dist : -1e30f;
                sc[j][i] = v; mx = fmaxf(mx, v);
            }
        mx = fmaxf(mx, __shfl_xor(mx, 16)); mx = fmaxf(mx, __shfl_xor(mx, 32));
        float sum = 0.f;
#pragma unroll
        for (int j = 0; j < 9; ++j)
#pragma unroll
            for (int i = 0; i < 4; ++i) { const float p = ex2(sc[j][i] - mx); sc[j][i] = p; sum += p; }
        sum += __shfl_xor(sum, 16); sum += __shfl_xor(sum, 32);
        const float inv = 1.0f / (sum + ex2(sink2 - mx));
        lds8* pw = lds + PS + w * PWAVE + r * PSTR;
#pragma unroll
        for (int j = 0; j < 9; ++j) { const int slot = j + (w & 1); u32x2 v; v.x = pkbf(sc[j][0] * inv, sc[j][1] * inv); v.y = pkbf(sc[j][2] * inv, sc[j][3] * inv); ldsw64(pw + (slot * 16 + 4 * q) * 2, v); }
        { const int zs = (w & 1) ? 0 : 9; ldsw64(pw + (zs * 16 + 4 * q) * 2, (u32x2){0u, 0u}); }
        f32x4 o[4];
#pragma unroll
        for (int et = 0; et < 4; ++et) o[et] = (f32x4){0.f, 0.f, 0.f, 0.f};
        const int s0 = 16 * (w & ~1);
#pragma unroll
        for (int ks = 0; ks < 5; ++ks) {
            const bf16x8 yp = ldsr128(pw + (32 * ks + 8 * q) * 2);
#pragma unroll
            for (int et = 0; et < 4; ++et) o[et] = mfma16(ldstr(lds + VS + (s0 + 32 * ks) * TRS + 32 * et, troff), yp, o[et]);
        }
        bf16_t* op = mix + (rowb + n * 128 + qi) * 1024 + 512 + head * 64 + 4 * q;
#pragma unroll
        for (int et = 0; et < 4; ++et) { u32x2 v; v.x = pkbf(o[et][0], o[et][1]); v.y = pkbf(o[et][2], o[et][3]); *(u32x2*)(op + 16 * et) = v; }
    }
    __syncthreads();
}

constexpr int RQ = 0, RK = 18432, RKD = 36864, RV = 55296, RP = 73728, RS = 108544, RSTR = 144, TSTR = 272;
__device__ __forceinline__ void ret_stage(lds8* lds, const bf16_t* __restrict__ proj, size_t rowbase, int h, float lg2, bool full) {
    const int tid = threadIdx.x;
    for (int idx = tid; idx < 1024; idx += 512) {
        const int row = idx >> 3, seg = idx & 7;
        const bf16_t* p = proj + (rowbase + row) * INW + h * 64 + seg * 8;
        const u32x4 kr = *(const u32x4*)(p + C_KR), vr = *(const u32x4*)(p + C_VR);
        float kf[8], kdv[8]; unpack8(kr, kf);
        const float kd = exp2f(lg2 * (float)(127 - row)) * 0.125f;
#pragma unroll
        for (int e = 0; e < 8; ++e) kdv[e] = kf[e] * kd;
        ldsw128(lds + RKD + row * RSTR + seg * 16, pack8(kdv));
        ldsw128(lds + RV + row * RSTR + seg * 16, vr);
        if (full) {
#pragma unroll
            for (int e = 0; e < 8; ++e) kf[e] *= 0.125f;
            ldsw128(lds + RK + row * RSTR + seg * 16, pack8(kf));
            ldsw128(lds + RQ + row * RSTR + seg * 16, *(const u32x4*)(p + C_QR));
        }
    }
}
__device__ __forceinline__ void ret_state_update(const lds8* lds, f32x4 (&st)[2], int w, int troff, float dec) {
    const int et = w >> 1, dt0 = 2 * (w & 1);
    st[0] = st[0] * dec; st[1] = st[1] * dec;
#pragma unroll
    for (int ks = 0; ks < 4; ++ks) {
        const bf16x8 a = ldstr(lds + RV + (32 * ks) * RSTR + 32 * et, troff);
#pragma unroll
        for (int t = 0; t < 2; ++t) st[t] = mfma16(a, ldstr(lds + RKD + (32 * ks) * RSTR + 32 * (dt0 + t), troff), st[t]);
    }
}
__device__ __forceinline__ void ret_chunk_out(lds8* lds, const bf16_t* __restrict__ proj, bf16_t* __restrict__ mix, size_t rowbase, int h, float lg2, int w, int r, int q, int troff) {
    const int l = 16 * w + r;
    const bf16x8 yq0 = ldsr128(lds + RQ + l * RSTR + 16 * q), yq1 = ldsr128(lds + RQ + l * RSTR + 16 * q + 64);
    lds8* prow = lds + RP + l * TSTR;
    for (int mt = 0; mt <= w; ++mt) {
        const lds8* kp = lds + RK + (16 * mt + r) * RSTR + 16 * q;
        f32x4 d = mfma16(ldsr128(kp), yq0, (f32x4){0.f, 0.f, 0.f, 0.f});
        d = mfma16(ldsr128(kp + 64), yq1, d);
        float pv[4];
#pragma unroll
        for (int i = 0; i < 4; ++i) { const int dl = l - (16 * mt + 4 * q + i); pv[i] = (dl >= 0) ? d[i] * exp2f(lg2 * (float)dl) : 0.f; }
        u32x2 v; v.x = pkbf(pv[0], pv[1]); v.y = pkbf(pv[2], pv[3]);
        ldsw64(prow + (16 * mt + 4 * q) * 2, v);
    }
    if ((w & 1) == 0) ldsw64(prow + (16 * (w + 1) + 4 * q) * 2, (u32x2){0u, 0u});
    const int nks = (w + 2) >> 1;
    f32x4 oi[4], oc[4];
#pragma unroll
    for (int et = 0; et < 4; ++et) { oi[et] = (f32x4){0.f, 0.f, 0.f, 0.f}; oc[et] = (f32x4){0.f, 0.f, 0.f, 0.f}; }
    for (int ks = 0; ks < nks; ++ks) {
        const bf16x8 yp = ldsr128(prow + (32 * ks + 8 * q) * 2);
#pragma unroll
        for (int et = 0; et < 4; ++et) oi[et] = mfma16(ldstr(lds + RV + (32 * ks) * RSTR + 32 * et, troff), yp, oi[et]);
    }
#pragma unroll
    for (int et = 0; et < 4; ++et) {
        oc[et] = mfma16(ldstr(lds + RS + 32 * et, troff), yq0, oc[et]);
        oc[et] = mfma16(ldstr(lds + RS + 32 * RSTR + 32 * et, troff), yq1, oc[et]);
    }
    const float qd = exp2f(lg2 * (float)(l + 1));
    float ss = 0.f;
#pragma unroll
    for (int et = 0; et < 4; ++et) { oi[et] = oi[et] + oc[et] * qd; ss += (oi[et][0] * oi[et][0] + oi[et][1] * oi[et][1]) + (oi[et][2] * oi[et][2] + oi[et][3] * oi[et][3]); }
    ss += __shfl_xor(ss, 16); ss += __shfl_xor(ss, 32);
    const float rstd = 1.0f / sqrtf(ss * (1.f / 64.f) + EPS);
    const bf16_t* gp = proj + (rowbase + l) * INW + C_GR + h * 64 + 4 * q;
    bf16_t* op = mix + (rowbase + l) * 1024 + h * 64 + 4 * q;
#pragma unroll
    for (int et = 0; et < 4; ++et) {
        const u32x2 gr = *(const u32x2*)(gp + 16 * et);
        const float g0 = bflo(gr.x), g1 = bfhi(gr.x), g2 = bflo(gr.y), g3 = bfhi(gr.y);
        const float s0 = g0 / (1.f + __expf(-g0)), s1 = g1 / (1.f + __expf(-g1)), s2 = g2 / (1.f + __expf(-g2)), s3 = g3 / (1.f + __expf(-g3));
        u32x2 v; v.x = pkbf(oi[et][0] * rstd * s0, oi[et][1] * rstd * s1); v.y = pkbf(oi[et][2] * rstd * s2, oi[et][3] * rstd * s3);
        *(u32x2*)(op + 16 * et) = v;
    }
}
__device__ __forceinline__ float ret_lg2(int h) { return log2f(1.0f - exp2f(-5.0f - (float)h)); }
__device__ __forceinline__ void ret_u_item(lds8* lds, const bf16_t* __restrict__ proj, float* __restrict__ ust, int b, int h, int c) {
    const int tid = threadIdx.x, lane = tid & 63, w = __builtin_amdgcn_readfirstlane(tid >> 6), r = lane & 15, q = lane >> 4;
    ret_stage(lds, proj, (size_t)b * 2048 + 128 * c, h, ret_lg2(h), false);
    __syncthreads();
    f32x4 st[2]; st[0] = (f32x4){0.f, 0.f, 0.f, 0.f}; st[1] = (f32x4){0.f, 0.f, 0.f, 0.f};
    ret_state_update(lds, st, w, tr_off(lane), 0.f);
    float* up = ust + ((size_t)((b * 8 + h) * 16 + c) * 16 + w * 2) * 256 + lane * 4;
    *(f32x4*)up = st[0]; *(f32x4*)(up + 256) = st[1];
    __syncthreads();
}
__device__ __forceinline__ void ret_item(lds8* lds, const bf16_t* __restrict__ proj, bf16_t* __restrict__ mix, const float* __restrict__ ust, float* __restrict__ out, int b, int h, int qq) {
    const int tid = threadIdx.x, lane = tid & 63, w = __builtin_amdgcn_readfirstlane(tid >> 6), r = lane & 15, q = lane >> 4;
    const float lg2 = ret_lg2(h), g128 = exp2f(lg2 * 128.f);
    const int et = w >> 1, dt0 = 2 * (w & 1), troff = tr_off(lane);
    f32x4 st[2]; st[0] = (f32x4){0.f, 0.f, 0.f, 0.f}; st[1] = (f32x4){0.f, 0.f, 0.f, 0.f};
    for (int j = 0; j < 4 * qq; ++j) {
        const float* up = ust + ((size_t)((b * 8 + h) * 16 + j) * 16 + w * 2) * 256 + lane * 4;
        st[0] = st[0] * g128 + *(const f32x4*)up; st[1] = st[1] * g128 + *(const f32x4*)(up + 256);
    }
    for (int cc = 0; cc < 4; ++cc) {
        const size_t rowbase = (size_t)b * 2048 + 128 * (4 * qq + cc);
#pragma unroll
        for (int t = 0; t < 2; ++t) { u32x2 v; v.x = pkbf(st[t][0], st[t][1]); v.y = pkbf(st[t][2], st[t][3]); ldsw64(lds + RS + (16 * (dt0 + t) + r) * RSTR + (16 * et + 4 * q) * 2, v); }
        ret_stage(lds, proj, rowbase, h, lg2, true);
        __syncthreads();
        ret_chunk_out(lds, proj, mix, rowbase, h, lg2, w, r, q, troff);
        ret_state_update(lds, st, w, troff, g128);
        __syncthreads();
    }
    if (qq == 3) {
#pragma unroll
        for (int t = 0; t < 2; ++t) *(f32x4*)(out + O_RETP + ((size_t)(b * 8 + h) * 64 + 16 * (dt0 + t) + r) * 64 + 16 * et + 4 * q) = st[t];
    }
}

__device__ __forceinline__ void sample_swa_item(lds8* lds, const bf16_t* __restrict__ proj, bf16_t* __restrict__ mix, float* __restrict__ out,
                                                const float* __restrict__ cache_k, const float* __restrict__ cache_v, const float* __restrict__ qg, const float* __restrict__ kg, const float* __restrict__ sinks, int b) {
    const int tid = threadIdx.x, lane = tid & 63, w = __builtin_amdgcn_readfirstlane(tid >> 6), r = lane & 15, q = lane >> 4, troff = tr_off(lane);
    constexpr int SK = 0, SKH = 144 * 144, SV = 2 * SKH, SVH = 160 * 144, SQ = SV + 2 * SVH, SP = SQ + 64 * 144, PSTR = 336, PWAVE = 5376;
    const size_t Rs = (size_t)MP + b * 8;
    for (int idx = tid; idx < 2048; idx += 512) {
        const int seg = idx & 7, kvh = (idx >> 3) & 1, j = idx >> 4;
        const size_t src = ((size_t)(b * 128 + j) * 2 + kvh) * 64 + seg * 8;
        const f32x4 k0 = *(const f32x4*)(cache_k + src), k1 = *(const f32x4*)(cache_k + src + 4), v0 = *(const f32x4*)(cache_v + src), v1 = *(const f32x4*)(cache_v + src + 4);
        u32x4 kp, vp; kp.x = pkbf(k0[0], k0[1]); kp.y = pkbf(k0[2], k0[3]); kp.z = pkbf(k1[0], k1[1]); kp.w = pkbf(k1[2], k1[3]);
        vp.x = pkbf(v0[0], v0[1]); vp.y = pkbf(v0[2], v0[3]); vp.z = pkbf(v1[0], v1[1]); vp.w = pkbf(v1[2], v1[3]);
        ldsw128(lds + SK + kvh * SKH + j * TRS + seg * 16, kp); ldsw128(lds + SV + kvh * SVH + j * TRS + seg * 16, vp);
        if (j >= 8) { const size_t dst = ((size_t)(b * 128 + j - 8) * 2 + kvh) * 64 + seg * 8;
            *(f32x4*)(out + O_KS + dst) = k0; *(f32x4*)(out + O_KS + dst + 4) = k1; *(f32x4*)(out + O_VS + dst) = v0; *(f32x4*)(out + O_VS + dst + 4) = v1; }
    }
    {
        const int rowq = tid >> 3, seg = tid & 7, kvh = rowq >> 5, g = (rowq >> 3) & 3, i = rowq & 7;
        const bf16_t* p = proj + (Rs + i) * INW + C_QS + (kvh * 4 + g) * 64 + seg * 8;
        float qf[8]; unpack8(*(const u32x4*)p, qf);
        float ss = 0.f;
#pragma unroll
        for (int e = 0; e < 8; ++e) ss += qf[e] * qf[e];
        ss += __shfl_xor(ss, 1); ss += __shfl_xor(ss, 2); ss += __shfl_xor(ss, 4);
        const float rstd = (0.125f * LOG2E) / sqrtf(ss * (1.f / 64.f) + EPS);
#pragma unroll
        for (int e = 0; e < 8; ++e) qf[e] *= rstd * qg[seg * 8 + e];
        ldsw128(lds + SQ + rowq * TRS + seg * 16, pack8(qf));
    }
    if (tid < 128) {
        const int seg = tid & 7, i = (tid >> 3) & 7, kvh = tid >> 6;
        const bf16_t* p = proj + (Rs + i) * INW + C_KS + kvh * 64 + seg * 8;
        const u32x4 vr = *(const u32x4*)(p + 128);
        float kf[8], vf[8]; unpack8(*(const u32x4*)p, kf); unpack8(vr, vf);
        float ss = 0.f;
#pragma unroll
        for (int e = 0; e < 8; ++e) ss += kf[e] * kf[e];
        ss += __shfl_xor(ss, 1); ss += __shfl_xor(ss, 2); ss += __shfl_xor(ss, 4);
        const float rstd = 1.0f / sqrtf(ss * (1.f / 64.f) + EPS);
#pragma unroll
        for (int e = 0; e < 8; ++e) kf[e] *= rstd * kg[seg * 8 + e];
        ldsw128(lds + SK + kvh * SKH + (128 + i) * TRS + seg * 16, pack8(kf)); ldsw128(lds + SV + kvh * SVH + (128 + i) * TRS + seg * 16, vr);
        const size_t dst = ((size_t)(b * 128 + 120 + i) * 2 + kvh) * 64 + seg * 8;
        *(f32x4*)(out + O_KS + dst) = (f32x4){kf[0], kf[1], kf[2], kf[3]}; *(f32x4*)(out + O_KS + dst + 4) = (f32x4){kf[4], kf[5], kf[6], kf[7]};
        *(f32x4*)(out + O_VS + dst) = (f32x4){vf[0], vf[1], vf[2], vf[3]}; *(f32x4*)(out + O_VS + dst + 4) = (f32x4){vf[4], vf[5], vf[6], vf[7]};
    }
    for (int i = tid; i < 2 * (8 + 24) * 9; i += 512) {
        const int kvh = i / 288, rr = (i % 288) / 9, c = i % 9;
        lds8* p = (rr < 8) ? lds + SK + kvh * SKH + (136 + rr) * TRS + c * 16 : lds + SV + kvh * SVH + (136 + rr - 8) * TRS + c * 16;
        ldsw128(p, (u32x4){0u, 0u, 0u, 0u});
    }
    __syncthreads();
    if (w < 4) {
        const int kvh = w >> 1, qt = w & 1, head = kvh * 4 + qt * 2 + (r >> 3), i = r & 7;
        const float slope2 = exp2f(-(float)(head + 1)) * LOG2E, sink2 = sinks[head] * LOG2E;
        const lds8* qp = lds + SQ + (kvh * 32 + qt * 16 + r) * TRS + 16 * q;
        const bf16x8 yq0 = ldsr128(qp), yq1 = ldsr128(qp + 64);
        f32x4 sc[9];
#pragma unroll
        for (int kt = 0; kt < 9; ++kt) {
            const lds8* kp = lds + SK + kvh * SKH + (16 * kt + r) * TRS + 16 * q;
            sc[kt] = mfma16(ldsr128(kp), yq0, (f32x4){0.f, 0.f, 0.f, 0.f});
            sc[kt] = mfma16(ldsr128(kp + 64), yq1, sc[kt]);
        }
        float mx = sink2;
#pragma unroll
        for (int kt = 0; kt < 9; ++kt)
#pragma unroll
            for (int ii = 0; ii < 4; ++ii) {
                const int key = 16 * kt + 4 * q + ii, dist = 128 + i - key;
                const float v = (dist >= 0 && dist < 128) ? sc[kt][ii] - slope2 * (float)dist : -1e30f;
                sc[kt][ii] = v; mx = fmaxf(mx, v);
            }
        mx = fmaxf(mx, __shfl_xor(mx, 16)); mx = fmaxf(mx, __shfl_xor(mx, 32));
        float sum = 0.f;
#pragma unroll
        for (int kt = 0; kt < 9; ++kt)
#pragma unroll
            for (int ii = 0; ii < 4; ++ii) { const float p = ex2(sc[kt][ii] - mx); sc[kt][ii] = p; sum += p; }
        sum += __shfl_xor(sum, 16); sum += __shfl_xor(sum, 32);
        const float inv = 1.0f / (sum + ex2(sink2 - mx));
        lds8* pw = lds + SP + w * PWAVE + r * PSTR;
#pragma unroll
        for (int kt = 0; kt < 9; ++kt) { u32x2 v; v.x = pkbf(sc[kt][0] * inv, sc[kt][1] * inv); v.y = pkbf(sc[kt][2] * inv, sc[kt][3] * inv); ldsw64(pw + (kt * 16 + 4 * q) * 2, v); }
        ldsw64(pw + (9 * 16 + 4 * q) * 2, (u32x2){0u, 0u});
        f32x4 o[4];
#pragma unroll
        for (int et = 0; et < 4; ++et) o[et] = (f32x4){0.f, 0.f, 0.f, 0.f};
#pragma unroll
        for (int ks = 0; ks < 5; ++ks) {
            const bf16x8 yp = ldsr128(pw + (32 * ks + 8 * q) * 2);
#pragma unroll
            for (int et = 0; et < 4; ++et) o[et] = mfma16(ldstr(lds + SV + kvh * SVH + (32 * ks) * TRS + 32 * et, troff), yp, o[et]);
        }
        bf16_t* op = mix + (Rs + i) * 1024 + 512 + head * 64 + 4 * q;
#pragma unroll
        for (int et = 0; et < 4; ++et) { u32x2 v; v.x = pkbf(o[et][0], o[et][1]); v.y = pkbf(o[et][2], o[et][3]); *(u32x2*)(op + 16 * et) = v; }
    }
    __syncthreads();
}
__device__ __forceinline__ void sample_ret_item(lds8* lds, const bf16_t* __restrict__ proj, bf16_t* __restrict__ mix, float* __restrict__ out, const float* __restrict__ state_ret, int b) {
    const int tid = threadIdx.x, lane = tid & 63, w = __builtin_amdgcn_readfirstlane(tid >> 6);
    const size_t Rs = (size_t)MP + b * 8;
    const int h = w;
    LAS float* qf = (LAS float*)(lds + w * 4608); LAS float* kf = qf + 512; LAS float* scl = kf + 512;
    const float lg2 = ret_lg2(h);
    float v[8], gg[8];
#pragma unroll
    for (int l = 0; l < 8; ++l) {
        const bf16_t* p = proj + (Rs + l) * INW + h * 64 + lane;
        qf[l * 64 + lane] = bf2f(p[C_QR]); kf[l * 64 + lane] = 0.125f * bf2f(p[C_KR]); v[l] = bf2f(p[C_VR]); gg[l] = bf2f(p[C_GR]);
    }
    float S[64];
    const float* sp = state_ret + ((size_t)(b * 8 + h) * 64) * 64 + lane;
#pragma unroll
    for (int d = 0; d < 64; ++d) S[d] = sp[d * 64];
    {
        const int l = lane >> 3, m = lane & 7; float dot = 0.f;
        const LAS f32x4* q4 = (const LAS f32x4*)(qf + l * 64); const LAS f32x4* k4 = (const LAS f32x4*)(kf + m * 64);
#pragma unroll
        for (int d4 = 0; d4 < 16; ++d4) { const f32x4 a = q4[d4], c = k4[d4]; dot += (a[0] * c[0] + a[1] * c[1]) + (a[2] * c[2] + a[3] * c[3]); }
        scl[lane] = (m <= l) ? dot * exp2f(lg2 * (float)(l - m)) : 0.f;
    }
#pragma unroll
    for (int l = 0; l < 8; ++l) {
        float cross = 0.f, intra = 0.f;
        const LAS f32x4* q4 = (const LAS f32x4*)(qf + l * 64);
#pragma unroll
        for (int d4 = 0; d4 < 16; ++d4) { const f32x4 a = q4[d4]; cross += (a[0] * S[4 * d4] + a[1] * S[4 * d4 + 1]) + (a[2] * S[4 * d4 + 2] + a[3] * S[4 * d4 + 3]); }
        const LAS f32x4* s4 = (const LAS f32x4*)(scl + l * 8); const f32x4 sa = s4[0], sb = s4[1];
        intra = (sa[0] * v[0] + sa[1] * v[1]) + (sa[2] * v[2] + sa[3] * v[3]) + (sb[0] * v[4] + sb[1] * v[5]) + (sb[2] * v[6] + sb[3] * v[7]);
        const float o = intra + exp2f(lg2 * (float)(l + 1)) * cross;
        const float ss = wave_sum(o * o);
        const float rstd = 1.0f / sqrtf(ss * (1.f / 64.f) + EPS);
        const float gl = gg[l], sil = gl / (1.f + __expf(-gl));
        mix[(Rs + l) * 1024 + h * 64 + lane] = (bf16_t)(pkbf(o * rstd * sil, 0.f) & 0xffffu);
    }
    const float g8 = exp2f(lg2 * 8.f);
#pragma unroll
    for (int d = 0; d < 64; ++d) S[d] *= g8;
#pragma unroll
    for (int m = 0; m < 8; ++m) {
        const float vk = v[m] * exp2f(lg2 * (float)(7 - m));
        const LAS f32x4* k4 = (const LAS f32x4*)(kf + m * 64);
#pragma unroll
        for (int d4 = 0; d4 < 16; ++d4) { const f32x4 c = k4[d4]; S[4 * d4] += c[0] * vk; S[4 * d4 + 1] += c[1] * vk; S[4 * d4 + 2] += c[2] * vk; S[4 * d4 + 3] += c[3] * vk; }
    }
    float* op = out + O_RETS + ((size_t)(b * 8 + h) * 64) * 64 + lane;
#pragma unroll
    for (int d = 0; d < 64; ++d) op[d * 64] = S[d];
    __syncthreads();
}

__device__ __forceinline__ void sample_item(lds8* lds, const bf16_t* __restrict__ proj, bf16_t* __restrict__ mix, float* __restrict__ out, const float* __restrict__ state_ret,
                                            const float* __restrict__ cache_k, const float* __restrict__ cache_v, const float* __restrict__ qg, const float* __restrict__ kg, const float* __restrict__ sinks, int b) {
    const int tid = threadIdx.x, lane = tid & 63, w = __builtin_amdgcn_readfirstlane(tid >> 6);
    LAS float* Kf = (LAS float*)(lds);
    LAS float* Vf = (LAS float*)(lds + 35360);
    LAS float* Qf = (LAS float*)(lds + 70176);
    LAS float* Pf = (LAS float*)(lds + 78368);
    const size_t Rs = (size_t)MP + b * 8;
    for (int kvh = 0; kvh < 2; ++kvh) {
        __syncthreads();
        for (int idx = tid; idx < 2048; idx += 512) {
            const int j = idx >> 4, c4 = idx & 15;
            const size_t src = ((size_t)(b * 128 + j) * 2 + kvh) * 64 + c4 * 4;
            const f32x4 kv = *(const f32x4*)(cache_k + src), vv = *(const f32x4*)(cache_v + src);
            LAS float* kd = Kf + j * 65 + c4 * 4; kd[0] = kv[0]; kd[1] = kv[1]; kd[2] = kv[2]; kd[3] = kv[3];
            *(LAS f32x4*)(Vf + j * 64 + c4 * 4) = vv;
            if (j >= 8) { const size_t dst = ((size_t)(b * 128 + j - 8) * 2 + kvh) * 64 + c4 * 4; *(f32x4*)(out + O_KS + dst) = kv; *(f32x4*)(out + O_VS + dst) = vv; }
        }
        if (tid < 64) {
            const int i = tid >> 3, seg = tid & 7;
            const bf16_t* p = proj + (Rs + i) * INW + C_KS + kvh * 64 + seg * 8;
            float kf[8], vf[8]; unpack8(*(const u32x4*)p, kf); unpack8(*(const u32x4*)(p + 128), vf);
            float ss = 0.f;
#pragma unroll
            for (int e = 0; e < 8; ++e) ss += kf[e] * kf[e];
            ss += __shfl_xor(ss, 1); ss += __shfl_xor(ss, 2); ss += __shfl_xor(ss, 4);
            const float rstd = 1.0f / sqrtf(ss * (1.f / 64.f) + EPS);
            const size_t dst = ((size_t)(b * 128 + 120 + i) * 2 + kvh) * 64 + seg * 8;
#pragma unroll
            for (int e = 0; e < 8; ++e) { kf[e] *= rstd * kg[seg * 8 + e]; Kf[(128 + i) * 65 + seg * 8 + e] = kf[e]; Vf[(128 + i) * 64 + seg * 8 + e] = vf[e]; out[O_KS + dst + e] = kf[e]; out[O_VS + dst + e] = vf[e]; }
        } else if (tid < 320) {
            const int idx = tid - 64, rowq = idx >> 3, seg = idx & 7, g = rowq >> 3, i = rowq & 7;
            const bf16_t* p = proj + (Rs + i) * INW + C_QS + (kvh * 4 + g) * 64 + seg * 8;
            float qf[8]; unpack8(*(const u32x4*)p, qf);
            float ss = 0.f;
#pragma unroll
            for (int e = 0; e < 8; ++e) ss += qf[e] * qf[e];
            ss += __shfl_xor(ss, 1); ss += __shfl_xor(ss, 2); ss += __shfl_xor(ss, 4);
            const float rstd = 0.125f / sqrtf(ss * (1.f / 64.f) + EPS);
#pragma unroll
            for (int e = 0; e < 8; ++e) Qf[rowq * 64 + seg * 8 + e] = qf[e] * rstd * qg[seg * 8 + e];
        }
        __syncthreads();
        for (int rr = 0; rr < 4; ++rr) {
            const int rowq = 4 * w + rr, g = rowq >> 3, i = rowq & 7, head = kvh * 4 + g;
            const float slope = exp2f(-(float)(head + 1)), sink = sinks[head];
            float s[3];
#pragma unroll
            for (int t = 0; t < 3; ++t) {
                const int j = lane + 64 * t; float v = -1e30f;
                if (j < 136) {
                    float dot = 0.f;
#pragma unroll 16
                    for (int d = 0; d < 64; ++d) dot += Qf[rowq * 64 + d] * Kf[j * 65 + d];
                    const int dist = 128 + i - j;
                    if (dist >= 0 && dist < 128) v = dot - slope * (float)dist;
                }
                s[t] = v;
            }
            float mx = wave_max(fmaxf(fmaxf(s[0], s[1]), s[2])); mx = fmaxf(mx, sink);
            float p[3], sum = 0.f;
#pragma unroll
            for (int t = 0; t < 3; ++t) { p[t] = __expf(s[t] - mx); sum += p[t]; }
            sum = wave_sum(sum);
            const float inv = 1.0f / (sum + __expf(sink - mx));
#pragma unroll
            for (int t = 0; t < 3; ++t) { const int j = lane + 64 * t; if (j < 136) Pf[w * 136 + j] = p[t] * inv; }
            float o = 0.f;
#pragma unroll 8
            for (int j = 0; j < 136; ++j) o += Pf[w * 136 + j] * Vf[j * 64 + lane];
            mix[(Rs + i) * 1024 + 512 + head * 64 + lane] = (bf16_t)(pkbf(o, 0.f) & 0xffffu);
        }
    }
    __syncthreads();
    {
        const int h = w;
        LAS float* qf = (LAS float*)(lds + w * 4608); LAS float* kf = qf + 512; LAS float* scl = kf + 512;
        const float lg2 = ret_lg2(h);
        float v[8], gg[8];
#pragma unroll
        for (int l = 0; l < 8; ++l) {
            const bf16_t* p = proj + (Rs + l) * INW + h * 64 + lane;
            qf[l * 64 + lane] = bf2f(p[C_QR]); kf[l * 64 + lane] = 0.125f * bf2f(p[C_KR]); v[l] = bf2f(p[C_VR]); gg[l] = bf2f(p[C_GR]);
        }
        float S[64];
        const float* sp = state_ret + ((size_t)(b * 8 + h) * 64) * 64 + lane;
#pragma unroll
        for (int d = 0; d < 64; ++d) S[d] = sp[d * 64];
        {
            const int l = lane >> 3, m = lane & 7; float dot = 0.f;
#pragma unroll 16
            for (int d = 0; d < 64; ++d) dot += qf[l * 64 + d] * kf[m * 64 + d];
            scl[lane] = (m <= l) ? dot * exp2f(lg2 * (float)(l - m)) : 0.f;
        }
#pragma unroll
        for (int l = 0; l < 8; ++l) {
            float cross = 0.f, intra = 0.f;
#pragma unroll
            for (int d = 0; d < 64; ++d) cross += qf[l * 64 + d] * S[d];
#pragma unroll
            for (int m = 0; m < 8; ++m) intra += scl[l * 8 + m] * v[m];
            const float o = intra + exp2f(lg2 * (float)(l + 1)) * cross;
            const float ss = wave_sum(o * o);
            const float rstd = 1.0f / sqrtf(ss * (1.f / 64.f) + EPS);
            const float gl = gg[l], sil = gl / (1.f + __expf(-gl));
            mix[(Rs + l) * 1024 + h * 64 + lane] = (bf16_t)(pkbf(o * rstd * sil, 0.f) & 0xffffu);
        }
        const float g8 = exp2f(lg2 * 8.f);
        float vk[8];
#pragma unroll
        for (int m = 0; m < 8; ++m) vk[m] = v[m] * exp2f(lg2 * (float)(7 - m));
        float* op = out + O_RETS + ((size_t)(b * 8 + h) * 64) * 64 + lane;
#pragma unroll
        for (int d = 0; d < 64; ++d) {
            float acc = S[d] * g8;
#pragma unroll
            for (int m = 0; m < 8; ++m) acc += kf[m * 64 + d] * vk[m];
            op[d * 64] = acc;
        }
    }
    __syncthreads();
}

#define XB_TMO      128
#define XB_XCNT(j)  (256  + 64 * (j))
#define XB_XSUB(j)  (1280 + 64 * (j))
#define XB_XGEN(j)  (2304 + 64 * (j))
#define XB_TOP      3328
#define XB_TOPGEN   3392
#define XCD_BAR_WORDS 3456
#define XB_SPIN_CAP (1u << 18)

__device__ __forceinline__ unsigned xb_ld(unsigned* p)              { return __hip_atomic_load(p, __ATOMIC_RELAXED, __HIP_MEMORY_SCOPE_AGENT); }
__device__ __forceinline__ unsigned xb_add(unsigned* p, unsigned v) { return __hip_atomic_fetch_add(p, v, __ATOMIC_RELAXED, __HIP_MEMORY_SCOPE_AGENT); }
__device__ __forceinline__ unsigned xb_xcc_id() { return (unsigned)__builtin_amdgcn_s_getreg((3 << 11) | 20) & 0xFu; }
#define XB_SPIN(cond, bar) do { unsigned _sp = 0; while (cond) { __builtin_amdgcn_s_sleep(1); \
    if ((++_sp & 255u) == 0u) { if (xb_ld(&(bar)[XB_TMO])) break; if (_sp > XB_SPIN_CAP) { atomicAdd(&(bar)[XB_TMO], 1u); break; } } } } while (0)

struct XcdBarrier {
    unsigned* bar; unsigned x;
    volatile LAS unsigned* st;
};

__device__ __forceinline__ XcdBarrier xcd_barrier_post(unsigned* bar, volatile LAS unsigned* st) {
    XcdBarrier b; b.bar = bar; b.x = xb_xcc_id(); b.st = st;
    if (threadIdx.x == 0) (void)xb_add(&bar[XB_XCNT(b.x)], 1u);
    return b;
}
__device__ __forceinline__ void xcd_barrier_complete(unsigned* bar, unsigned x, unsigned& nloc, unsigned& nx) {
    const unsigned G = gridDim.x * gridDim.y * gridDim.z;
    unsigned sum, cnt, mine, sp = 0u;
    for (;;) {
        sum = 0u; cnt = 0u; mine = 0u;
#pragma unroll
        for (unsigned j = 0; j < 16; ++j) { const unsigned c = xb_ld(&bar[XB_XCNT(j)]); sum += c; cnt += (c > 0u) ? 1u : 0u; mine = (j == x) ? c : mine; }
        if (sum == G) break;
        __builtin_amdgcn_s_sleep(1);
        if ((++sp & 255u) == 0u) { if (xb_ld(&bar[XB_TMO])) break; if (sp > XB_SPIN_CAP) { atomicAdd(&bar[XB_TMO], 1u); break; } }
    }
    nloc = mine > 0u ? mine : 1u; nx = cnt > 0u ? cnt : 1u;
}

__device__ __forceinline__ void xcd_barrier(const XcdBarrier& b) {
    asm volatile("s_waitcnt vmcnt(0)" ::: "memory");
    __syncthreads();
    if (threadIdx.x == 0) {
        unsigned* bar = b.bar;
        __builtin_amdgcn_s_waitcnt(0);
        unsigned nloc = b.st[0], nx = b.st[1];
        if (nloc == 0u) { xcd_barrier_complete(bar, b.x, nloc, nx); b.st[0] = nloc; b.st[1] = nx; }
        const unsigned old = xb_add(&bar[XB_XSUB(b.x)], 1u);
        const unsigned gen = old / nloc;
        if (old + 1u == (gen + 1u) * nloc) {
            __builtin_amdgcn_fence(__ATOMIC_RELEASE, "agent");
            asm volatile("s_waitcnt vmcnt(0)" ::: "memory");
            const unsigned og = xb_add(&bar[XB_TOP], 1u);
            const unsigned tg = og / nx;
            if (og + 1u == (tg + 1u) * nx) xb_add(&bar[XB_TOPGEN], 1u);
            else XB_SPIN(xb_ld(&bar[XB_TOPGEN]) == tg, bar);
            __builtin_amdgcn_fence(__ATOMIC_ACQUIRE, "agent");
            xb_add(&bar[XB_XGEN(b.x)], 1u);
            asm volatile("s_waitcnt vmcnt(0)" ::: "memory");
        } else {
            XB_SPIN(xb_ld(&bar[XB_XGEN(b.x)]) == gen, bar);
            __builtin_amdgcn_fence(__ATOMIC_ACQUIRE, "agent");
            asm volatile("s_waitcnt vmcnt(0)" ::: "memory");
        }
    }
    __syncthreads();
}

struct Args { const float* in[14]; float* out; unsigned char* ws; };
#ifndef PHM
#define PHM 0x7f
#endif
constexpr int SWA_HS = 2;
constexpr int NI_SWA = 8 * 16 * 2 * (4 / SWA_HS), NI_U = 8 * 8 * 15, NI_SMP = 256;

typedef const __attribute__((address_space(4))) Args* kargs_t;
__device__ __forceinline__ kargs_t argp() { kargs_t p = (kargs_t)__builtin_amdgcn_kernarg_segment_ptr(); asm volatile("" : "+s"(p)); return p; }

__global__ void __launch_bounds__(512, 2) fwd_kernel(Args a_unused) {
    extern __shared__ __attribute__((aligned(16))) unsigned char lds_raw[];
    lds8* lds = (lds8*)lds_raw;
    cg::grid_group grid = cg::this_grid();
    const int tid = threadIdx.x, lane = tid & 63, wave = __builtin_amdgcn_readfirstlane(tid >> 6);
    const int G = gridDim.x, bid = blockIdx.x;
    volatile LAS unsigned* bst = (volatile LAS unsigned*)(lds + LDS_BYTES - 64);
    if (tid < 2) bst[tid] = 0u;
    { kargs_t ap = argp(); unsigned* bw = (unsigned*)(ap->ws + WS_BAR); if (bid == 0) for (int i = tid; i < XCD_BAR_WORDS; i += 512) bw[i] = 0u; }
    __syncthreads();

    if (PHM & 1) {
        kargs_t ap = argp(); unsigned char* ws = ap->ws;
        LAS float* scr = (LAS float*)(lds + wave * 16384);
        const int gw = bid * 8 + wave, NGW = G * 8;
        constexpr int I_IN = (D / 64) * (INW / 32), I_OUT = (D / 64) * (D / 32), I_UP = (D / 64) * (FF / 32), I_DN = (FF / 64) * (D / 32);
        for (int it = gw; it < I_IN + I_OUT + I_UP + I_DN; it += NGW) {
            int r = it;
            if (r < I_IN) { transpose_item(ap->in[6], D, INW, (bf16_t*)(ws + WS_WIN), nullptr, scr, r, lane); continue; } r -= I_IN;
            if (r < I_OUT) { transpose_item(ap->in[10], D, D, (bf16_t*)(ws + WS_WOUT), nullptr, scr, r, lane); continue; } r -= I_OUT;
            if (r < I_UP) { transpose_item(ap->in[12], D, FF, (bf16_t*)(ws + WS_WUP), ap->in[11], scr, r, lane); continue; } r -= I_UP;
            transpose_item(ap->in[13], FF, D, (bf16_t*)(ws + WS_WDN), nullptr, scr, r, lane);
        }
        const float* x_prompt = ap->in[0]; const float* x_sample = ap->in[1]; const float* g_mix = ap->in[5];
        bf16_t* XN = (bf16_t*)(ws + WS_XN);
        for (int m = gw; m < M; m += NGW) {
            const float* xr = (m < MP) ? x_prompt + (size_t)m * D : x_sample + (size_t)(m - MP) * D;
            rms_row_to_bf16(xr, g_mix, XN + (size_t)m * D, lane);
        }
        float* rowss = (float*)(ws + WS_CTL);
        for (int i = bid * 512 + tid; i < M; i += G * 512) rowss[i] = 0.f;
    }
    grid.sync();
    XcdBarrier bar; { kargs_t ap = argp(); bar = xcd_barrier_post((unsigned*)(ap->ws + WS_BAR), bst); }
#define GSYNC() xcd_barrier(bar)

    if (PHM & 2) {
        kargs_t ap = argp(); unsigned char* ws = ap->ws;
        pg8::Gemm g{(const bf16_t*)(ws + WS_XN), (const bf16_t*)(ws + WS_WIN), M, INW, D}; pg8::StaticOrder S; S.init(M, INW, D, G, bid);
        pg8::EpiBf16<0> E{(bf16_t*)(ws + WS_PROJ), INW, nullptr};
        pg8::gemm_phase<pg8::EpiBf16<0>, pg8::StaticOrder, true, true>(lds, g, S, E);
    }
    GSYNC();

#ifdef DUPA
    for (int rep = 0; rep < 2; ++rep) { if (rep) GSYNC();
#endif
#ifndef REP_SWA
#define REP_SWA 1
#endif
#ifndef REP_U
#define REP_U 1
#endif
#ifndef REP_SMP
#define REP_SMP 1
#endif
    if (PHM & 4) {
        for (int rep = 0; rep < REP_SWA; ++rep)
        for (int it = bid; it < NI_SWA; it += G) {
            kargs_t ap = argp(); unsigned char* ws = ap->ws;
            constexpr int HP = 4 / SWA_HS;
            const int hp = it % HP, kvh = (it / HP) & 1, n = (it / (2 * HP)) & 15, b = it / (32 * HP);
            swa_prompt_item(lds, (const bf16_t*)(ws + WS_PROJ), (bf16_t*)(ws + WS_MIX), ap->out, ap->in[7], ap->in[8], ap->in[9], b, n, kvh, hp * SWA_HS, SWA_HS);
        }
        for (int rep = 0; rep < REP_U; ++rep)
        for (int it = bid; it < NI_U; it += G) {
            kargs_t ap = argp(); unsigned char* ws = ap->ws;
            const int c = it % 15, h = (it / 15) & 7, b = it / 120;
            ret_u_item(lds, (const bf16_t*)(ws + WS_PROJ), (float*)(ws + WS_UST), b, h, c);
        }
        for (int rep = 0; rep < REP_SMP; ++rep)
        for (int it = bid; it < NI_SMP; it += G) {
            kargs_t ap = argp(); unsigned char* ws = ap->ws;
#if defined(TESTSEL) && TESTSEL == 3
            if (it < 128) { sample_swa_item(lds, (const bf16_t*)(ws + WS_PROJ), (bf16_t*)(ws + WS_MIX), ap->out, ap->in[3], ap->in[4], ap->in[7], ap->in[8], ap->in[9], it);
                sample_ret_item(lds, (const bf16_t*)(ws + WS_PROJ), (bf16_t*)(ws + WS_MIX), ap->out, ap->in[2], it); }
#elif defined(TESTSEL)
            if (it < 128) { sample_item(lds, (const bf16_t*)(ws + WS_PROJ), (bf16_t*)(ws + WS_MIX), ap->out, ap->in[2], ap->in[3], ap->in[4], ap->in[7], ap->in[8], ap->in[9], it);
                if (TESTSEL == 1) sample_ret_item(lds, (const bf16_t*)(ws + WS_PROJ), (bf16_t*)(ws + WS_MIX), ap->out, ap->in[2], it);
                else sample_swa_item(lds, (const bf16_t*)(ws + WS_PROJ), (bf16_t*)(ws + WS_MIX), ap->out, ap->in[3], ap->in[4], ap->in[7], ap->in[8], ap->in[9], it); }
#else
            if (it < 128) sample_swa_item(lds, (const bf16_t*)(ws + WS_PROJ), (bf16_t*)(ws + WS_MIX), ap->out, ap->in[3], ap->in[4], ap->in[7], ap->in[8], ap->in[9], it);
            else sample_ret_item(lds, (const bf16_t*)(ws + WS_PROJ), (bf16_t*)(ws + WS_MIX), ap->out, ap->in[2], it - 128);
#endif
        }
    }
#ifdef DUPA
    }
#endif
    GSYNC();

#ifdef DUPB
    for (int rep = 0; rep < 2; ++rep) { if (rep) GSYNC();
#endif
    if (PHM & 8) for (int it = bid; it < 256; it += G) {
        kargs_t ap = argp(); unsigned char* ws = ap->ws;
        ret_item(lds, (const bf16_t*)(ws + WS_PROJ), (bf16_t*)(ws + WS_MIX), (const float*)(ws + WS_UST), ap->out, it >> 5, (it >> 2) & 7, it & 3);
    }
#ifdef DUPB
    }
#endif
#ifdef XSYNC
    for (int rep = 0; rep < XSYNC; ++rep) GSYNC();
#endif
    GSYNC();

    if (PHM & 16) {
        kargs_t ap = argp(); unsigned char* ws = ap->ws;
        pg8::Gemm g{(const bf16_t*)(ws + WS_MIX), (const bf16_t*)(ws + WS_WOUT), M, D, D}; pg8::StaticOrder S; S.init(M, D, D, G, bid);
        pg8::EpiRes E{ap->in[0], ap->in[1], ap->out, (bf16_t*)(ws + WS_XN), (float*)(ws + WS_CTL)};
        pg8::gemm_phase<pg8::EpiRes, pg8::StaticOrder, true, true>(lds, g, S, E);
    }
    GSYNC();

    if (PHM & 32) {
        kargs_t ap = argp(); unsigned char* ws = ap->ws;
        pg8::Gemm g{(const bf16_t*)(ws + WS_XN), (const bf16_t*)(ws + WS_WUP), M, FF, D}; pg8::StaticOrder S; S.init(M, FF, D, G, bid);
        pg8::EpiBf16<1> E{(bf16_t*)(ws + WS_U), FF, (const float*)(ws + WS_CTL)};
        pg8::gemm_phase<pg8::EpiBf16<1>, pg8::StaticOrder, true, true>(lds, g, S, E);
    }
    GSYNC();

    if (PHM & 64) {
        kargs_t ap = argp(); unsigned char* ws = ap->ws;
        pg8::Gemm g{(const bf16_t*)(ws + WS_U), (const bf16_t*)(ws + WS_WDN), M, D, FF}; pg8::DownOrder S; S.init(FF, G, bid);
        pg8::EpiDown E{ap->out, (float*)(ws + WS_PART)};
        pg8::gemm_phase<pg8::EpiDown, pg8::DownOrder, true, true>(lds, g, S, E);
    }
    GSYNC();
    if (PHM & 64) {
        kargs_t ap = argp(); const f32x4* part = (const f32x4*)(ap->ws + WS_PART); f32x4* ys = (f32x4*)(ap->out + (size_t)MP * D);
        for (int i = bid * 512 + tid; i < MS * D / 4; i += G * 512) {
            f32x4 v = ys[i];
#pragma unroll
            for (int sidx = 0; sidx < pg8::DN_SLICES; ++sidx) v = v + part[(size_t)sidx * (MS * D / 4) + i];
            ys[i] = v;
        }
    }
}

extern "C" void kernel_launch(void* const* d_in, const int* in_sizes, int n_in, void* d_out, int out_size, void* d_ws, size_t ws_size, hipStream_t stream) {
    static int grid = 0;
    if (grid == 0) {
        int dev = 0, cus = 0, per_cu = 0;
        (void)hipGetDevice(&dev);
        (void)hipDeviceGetAttribute(&cus, hipDeviceAttributeMultiprocessorCount, dev);
        if (hipFuncSetAttribute((const void*)fwd_kernel, hipFuncAttributeMaxDynamicSharedMemorySize, LDS_BYTES) != hipSuccess) fprintf(stderr, "kernel_launch: hipFuncSetAttribute failed\n");
        if (hipOccupancyMaxActiveBlocksPerMultiprocessor(&per_cu, (const void*)fwd_kernel, 512, LDS_BYTES) != hipSuccess || per_cu < 1) per_cu = 1;
        (void)hipGetLastError();
        if (cus <= 0) cus = 256;
        grid = cus * per_cu;
    }
    Args a{};
    for (int i = 0; i < 14; ++i) a.in[i] = (const float*)d_in[i];
    a.out = (float*)d_out; a.ws = (unsigned char*)d_ws;
    void* params[] = {&a};
    hipError_t e = hipLaunchCooperativeKernel((const void*)fwd_kernel, dim3(grid), dim3(512), params, LDS_BYTES, stream);
    if (e != hipSuccess) fprintf(stderr, "kernel_launch: cooperative launch failed: %s (grid %d)\n", hipGetErrorString(e), grid);
}
```
